# Optimizing an MI355X kernel written in HIP

```python
import math
import jax, jax.numpy as jnp
from jax import lax
import numpy as np

D_MODEL = 1024
BATCH = 16
SEQ = 4096
DEPTH = 4

N_MIXERS = 3
EPS = 1e-6
NEG_BIG = -1e30

POOL_WINDOWS = (2, 4, 8, 16)
POOL_WIDTH = 2 * D_MODEL
POOL_GROUP = POOL_WIDTH // len(POOL_WINDOWS)

ATT_GROUPS = ((128, 1), (512, 4), (2048, 16))
ATT_HEAD_DIM = 128
ATT_HEADS = D_MODEL // ATT_HEAD_DIM
ATT_WIDTH = ATT_HEADS * ATT_HEAD_DIM
ROPE_DIM = ATT_HEAD_DIM // 4
ROPE_THETA = 500000.0

RET_HEADS = 4
RET_QK_DIM = D_MODEL // RET_HEADS
RET_V_DIM = 2 * D_MODEL // RET_HEADS
RET_QK = RET_HEADS * RET_QK_DIM
RET_V = RET_HEADS * RET_V_DIM
RET_CHUNK = 128
RET_THETA = 10000.0
RET_DECAY_BASE = 5.0

N_POOL_LAYERS = len(range(0, DEPTH, N_MIXERS))
N_ATT_LAYERS = len(range(1, DEPTH, N_MIXERS))
N_RET_LAYERS = len(range(2, DEPTH, N_MIXERS))

kernel_name = "hybrid_pool_dilattn_retention_encoder"

F32 = jnp.float32


def rms_norm(x, w):
    x32 = x.astype(F32)
    y = x32 * lax.rsqrt(jnp.mean(x32 * x32, axis=-1, keepdims=True) + EPS)
    return (y * w.astype(F32)).astype(x.dtype)


def rotary(x, pos, rot_dim, theta):
    half = rot_dim // 2
    inv_freq = 1.0 / (theta ** (jnp.arange(half, dtype=F32) * 2.0 / rot_dim))
    ang = pos.astype(F32)[:, None] * inv_freq[None, :]
    cos = jnp.cos(ang)[None, :, None, :]
    sin = jnp.sin(ang)[None, :, None, :]
    xr = x[..., :rot_dim].astype(F32)
    x1, x2 = xr[..., :half], xr[..., half:]
    rot = jnp.concatenate([x1 * cos - x2 * sin, x2 * cos + x1 * sin], axis=-1).astype(x.dtype)
    return jnp.concatenate([rot, x[..., rot_dim:]], axis=-1)


def centred_window_mean(u, window):
    B, S, C = u.shape
    cs = jnp.concatenate([jnp.zeros((B, 1, C), F32), jnp.cumsum(u.astype(F32), axis=1)], axis=1)
    t = jnp.arange(S)
    lo = jnp.clip(t - window // 2, 0, S)
    hi = jnp.clip(t - window // 2 + window, 0, S)
    count = (hi - lo).astype(F32)
    return (cs[:, hi] - cs[:, lo]) / count[None, :, None]


def pool_mixer(h, w_in, w_group, scale, w_out):
    B, S, _ = h.shape
    proj = h @ w_in
    u, gate = proj[..., :POOL_WIDTH], proj[..., POOL_WIDTH:]
    ug = u.reshape(B, S, len(POOL_WINDOWS), POOL_GROUP)
    pooled = jnp.stack([centred_window_mean(ug[:, :, g], w) for g, w in enumerate(POOL_WINDOWS)], axis=2)
    diff = (pooled - ug.astype(F32)).astype(h.dtype)
    mixed = jnp.einsum('bsgc,gcd->bsgd', diff, w_group).reshape(B, S, POOL_WIDTH) * scale
    return (mixed * jax.nn.silu(gate)) @ w_out


def dilated_window_attention(q, k, v, dilation, n_side):
    B, S, H, Dh = q.shape
    blk = n_side
    seg = dilation * blk
    Sp = -(-S // seg) * seg
    nblk = Sp // seg

    def to_sub(t):
        t = jnp.pad(t, ((0, 0), (0, Sp - S), (0, 0), (0, 0)))
        return t.reshape(B, nblk, blk, dilation, H, Dh).transpose(0, 3, 1, 2, 4, 5)

    def band(t):
        tp = jnp.pad(t, ((0, 0), (0, 0), (1, 1), (0, 0), (0, 0), (0, 0)))
        return jnp.concatenate([tp[:, :, :-2], tp[:, :, 1:-1], tp[:, :, 2:]], axis=3)

    qb = to_sub(q)
    kw, vw = band(to_sub(k)), band(to_sub(v))

    r = jnp.arange(dilation)[:, None, None]
    bidx = jnp.arange(nblk)[None, :, None]
    c = jnp.arange(3 * blk)
    key_sub = (bidx - 1) * blk + c[None, None, :]
    key_pos = key_sub * dilation + r
    key_ok = (key_sub >= 0) & (key_pos < S)
    offs = c[None, :] - blk - jnp.arange(blk)[:, None]
    band_ok = jnp.abs(offs) <= n_side
    mask = key_ok[:, :, None, :] & band_ok[None, None]

    scores = jnp.einsum('brnqhe,brnkhe->brnhqk', qb, kw).astype(F32) * (Dh ** -0.5)
    scores = jnp.where(mask[None, :, :, None], scores, NEG_BIG)
    m = jnp.max(scores, axis=-1, keepdims=True)
    p = jnp.exp(scores - m)
    den = jnp.sum(p, axis=-1, keepdims=True)
    o = jnp.einsum('brnhqk,brnkhe->brnhqe', p, vw.astype(F32)) / den
    lse = (m + jnp.log(den))[..., 0]
    o = o.transpose(0, 2, 4, 1, 3, 5).reshape(B, Sp, H, Dh)[:, :S]
    lse = lse.transpose(0, 2, 4, 1, 3).reshape(B, Sp, H)[:, :S]
    return o, lse


def dilated_attention_mixer(h, w_in, q_norm, k_norm, w_out):
    B, S, _ = h.shape
    n_g = len(ATT_GROUPS)
    proj = h @ w_in
    qkv = proj[..., :3 * n_g * ATT_WIDTH].reshape(B, S, n_g, 3, ATT_HEADS, ATT_HEAD_DIM)
    gate = proj[..., 3 * n_g * ATT_WIDTH:]
    pos = jnp.arange(S)
    outs, lses = [], []
    for g, (window, dil) in enumerate(ATT_GROUPS):
        q = rotary(rms_norm(qkv[:, :, g, 0], q_norm[g]), pos, ROPE_DIM, ROPE_THETA)
        k = rotary(rms_norm(qkv[:, :, g, 1], k_norm[g]), pos, ROPE_DIM, ROPE_THETA)
        o, lse = dilated_window_attention(q, k, qkv[:, :, g, 2], dil, window // (2 * dil))
        outs.append(o)
        lses.append(lse)
    weights = jax.nn.softmax(jnp.stack(lses, axis=0), axis=0)
    o = jnp.einsum('gbsh,gbshe->bshe', weights, jnp.stack(outs, axis=0))
    y = o.reshape(B, S, ATT_WIDTH).astype(h.dtype) * jax.nn.silu(gate)
    return y @ w_out


def retention_scan(q, k, v, log_gamma, include_diag):
    B, S, H, dk = q.shape
    dv = v.shape[-1]
    C = RET_CHUNK
    N = S // C

    def chunks(t):
        return t.astype(F32).reshape(B, N, C, H, t.shape[-1]).transpose(1, 0, 3, 2, 4)

    qc, kc, vc = chunks(q), chunks(k), chunks(v)
    i = jnp.arange(C, dtype=F32)
    diff = i[:, None] - i[None, :]
    keep = (diff >= 0) if include_diag else (diff > 0)
    inner_decay = jnp.where(keep[None], jnp.exp(jnp.where(keep, diff, 0.0)[None] * log_gamma[:, None, None]), 0.0)
    q_decay = jnp.exp((i + 1.0)[None, :] * log_gamma[:, None])[..., None]
    k_decay = jnp.exp((C - 1.0 - i)[None, :] * log_gamma[:, None])[..., None]
    chunk_decay = jnp.exp(C * log_gamma)[:, None, None]

    def step(state, inp):
        qi, ki, vi = inp
        inner = jnp.einsum('bhqd,bhkd->bhqk', qi, ki) * inner_decay
        out = jnp.einsum('bhqk,bhkv->bhqv', inner, vi) + jnp.einsum('bhqd,bhdv->bhqv', qi * q_decay, state)
        state = state * chunk_decay + jnp.einsum('bhkd,bhkv->bhdv', ki * k_decay, vi)
        return state, out

    _, out = lax.scan(step, jnp.zeros((B, H, dk, dv), F32), (qc, kc, vc))
    return out.transpose(1, 0, 3, 2, 4).reshape(B, S, H, dv)


def retention_mixer(h, w_in, decay_exp, w_out):
    B, S, _ = h.shape
    proj = h @ w_in
    qf, kf, qb, kb, v, gate = jnp.split(proj, [RET_QK, 2 * RET_QK, 3 * RET_QK, 4 * RET_QK, 4 * RET_QK + RET_V], axis=-1)
    pos = jnp.arange(S)
    scale = RET_QK_DIM ** -0.5

    def rot(t):
        return rotary(t.reshape(B, S, RET_HEADS, RET_QK_DIM), pos, RET_QK_DIM, RET_THETA)

    vh = v.reshape(B, S, RET_HEADS, RET_V_DIM)
    log_gamma = jnp.log1p(-jnp.exp2(-decay_exp.astype(F32)))
    fwd = retention_scan(rot(qf), rot(kf) * scale, vh, log_gamma[0], True)
    bwd = retention_scan(rot(qb)[:, ::-1], (rot(kb) * scale)[:, ::-1], vh[:, ::-1], log_gamma[1], False)[:, ::-1]
    y = fwd + bwd
    y = y * lax.rsqrt(jnp.mean(y * y, axis=-1, keepdims=True) + EPS)
    y = y.reshape(B, S, RET_V).astype(h.dtype) * jax.nn.silu(gate)
    return y @ w_out


def setup_inputs(seed: int = 0) -> dict:
    key = jax.random.key(seed)
    ks = jax.random.split(key, 20)
    n_g = len(ATT_GROUPS)

    def dense(k, shape, fan_in):
        return jax.random.normal(k, shape, F32) * (fan_in ** -0.5)

    def gain(k, shape):
        return 1.0 + 0.02 * jax.random.normal(k, shape, F32)

    x = jax.random.normal(ks[0], (BATCH, SEQ, D_MODEL), F32)
    pool_norm = gain(ks[1], (N_POOL_LAYERS, D_MODEL))
    pool_w_in = dense(ks[2], (N_POOL_LAYERS, D_MODEL, 2 * POOL_WIDTH), D_MODEL)
    pool_w_group = dense(ks[3], (N_POOL_LAYERS, len(POOL_WINDOWS), POOL_GROUP, POOL_GROUP), POOL_GROUP)
    pool_scale = gain(ks[4], (N_POOL_LAYERS, POOL_WIDTH))
    pool_w_out = dense(ks[5], (N_POOL_LAYERS, POOL_WIDTH, D_MODEL), POOL_WIDTH)
    att_norm = gain(ks[6], (N_ATT_LAYERS, D_MODEL))
    att_w_in = dense(ks[7], (N_ATT_LAYERS, D_MODEL, 3 * n_g * ATT_WIDTH + ATT_WIDTH), D_MODEL)
    att_q_norm = gain(ks[8], (N_ATT_LAYERS, n_g, ATT_HEAD_DIM))
    att_k_norm = gain(ks[9], (N_ATT_LAYERS, n_g, ATT_HEAD_DIM))
    att_w_out = dense(ks[10], (N_ATT_LAYERS, ATT_WIDTH, D_MODEL), ATT_WIDTH)
    ret_norm = gain(ks[11], (N_RET_LAYERS, D_MODEL))
    ret_w_in = dense(ks[12], (N_RET_LAYERS, D_MODEL, 4 * RET_QK + 2 * RET_V), D_MODEL)
    ret_decay = (RET_DECAY_BASE + jnp.arange(RET_HEADS, dtype=F32))[None, None, :] \
        + 0.1 * jax.random.normal(ks[13], (N_RET_LAYERS, 2, RET_HEADS), F32)
    ret_w_out = dense(ks[14], (N_RET_LAYERS, RET_V, D_MODEL), RET_V)
    return {"x": x,
            "pool_norm": pool_norm, "pool_w_in": pool_w_in, "pool_w_group": pool_w_group,
            "pool_scale": pool_scale, "pool_w_out": pool_w_out,
            "att_norm": att_norm, "att_w_in": att_w_in, "att_q_norm": att_q_norm,
            "att_k_norm": att_k_norm, "att_w_out": att_w_out,
            "ret_norm": ret_norm, "ret_w_in": ret_w_in, "ret_decay": ret_decay, "ret_w_out": ret_w_out}


def reference(x, pool_norm, pool_w_in, pool_w_group, pool_scale, pool_w_out,
              att_norm, att_w_in, att_q_norm, att_k_norm, att_w_out,
              ret_norm, ret_w_in, ret_decay, ret_w_out):
    for layer in range(DEPTH):
        kind, idx = layer % N_MIXERS, layer // N_MIXERS
        if kind == 0:
            h = rms_norm(x, pool_norm[idx])
            x = x + pool_mixer(h, pool_w_in[idx], pool_w_group[idx], pool_scale[idx], pool_w_out[idx])
        elif kind == 1:
            h = rms_norm(x, att_norm[idx])
            x = x + dilated_attention_mixer(h, att_w_in[idx], att_q_norm[idx], att_k_norm[idx], att_w_out[idx])
        else:
            h = rms_norm(x, ret_norm[idx])
            x = x + retention_mixer(h, ret_w_in[idx], ret_decay[idx], ret_w_out[idx])
    return x
```

```cpp
#include <hip/hip_runtime.h>
#include <hip/hip_cooperative_groups.h>
#include <cstdio>
namespace cg = cooperative_groups;

#define LAS __attribute__((address_space(3)))
typedef unsigned short bf16_t;
typedef short bf16x8 __attribute__((ext_vector_type(8)));
typedef short s16x4 __attribute__((ext_vector_type(4)));
typedef float f32x4 __attribute__((ext_vector_type(4)));
typedef unsigned u32x4 __attribute__((ext_vector_type(4)));
typedef unsigned u32x2 __attribute__((ext_vector_type(2)));

constexpr int SEQ = 4096, DM = 1024, NB = 16;
constexpr int HB = 8;
constexpr int MH = HB * SEQ;
constexpr float EPS = 1e-6f;
constexpr size_t MiB = 1024ull * 1024ull;
constexpr size_t WS_WT_POOL_IN  = 0;
constexpr size_t WS_WT_POOL_G   = 16 * MiB;
constexpr size_t WS_WT_POOL_OUT = 20 * MiB;
constexpr size_t WS_WT_ATT_IN   = 28 * MiB;
constexpr size_t WS_WT_ATT_OUT  = 48 * MiB;
constexpr size_t WS_WT_RET_IN   = 50 * MiB;
constexpr size_t WS_WT_RET_OUT  = 66 * MiB;
constexpr size_t WS_RET_COS     = 70 * MiB;
constexpr size_t WS_RET_SIN     = 72 * MiB;
constexpr size_t WS_ATT_COS     = 74 * MiB;
constexpr size_t WS_ATT_SIN     = 74 * MiB + 512 * 1024;
constexpr size_t WS_LSE         = 75 * MiB;
constexpr size_t WS_H           = 78 * MiB;
constexpr size_t WS_PROJ        = 142 * MiB;
constexpr size_t WS_END         = 142 * MiB + 768 * MiB;

struct Params {
    const float* x; const float* pool_norm; const float* pool_w_in; const float* pool_w_group; const float* pool_scale; const float* pool_w_out;
    const float* att_norm; const float* att_w_in; const float* att_q_norm; const float* att_k_norm; const float* att_w_out;
    const float* ret_norm; const float* ret_w_in; const float* ret_decay; const float* ret_w_out;
    float* out; unsigned char* ws;
};

typedef float f32x2 __attribute__((ext_vector_type(2)));
typedef __bf16 bf16x2_t __attribute__((ext_vector_type(2)));
__device__ __forceinline__ unsigned cvt_pk_bf16(float lo, float hi) { f32x2 v = {lo, hi}; return __builtin_bit_cast(unsigned, __builtin_convertvector(v, bf16x2_t)); }
__device__ __forceinline__ float bf_lo(unsigned w) { return __uint_as_float(w << 16); }
__device__ __forceinline__ float bf_hi(unsigned w) { return __uint_as_float(w & 0xffff0000u); }
__device__ __forceinline__ f32x4 mfma16(bf16x8 a, bf16x8 b, f32x4 c) { return __builtin_amdgcn_mfma_f32_16x16x32_bf16(a, b, c, 0, 0, 0); }
__device__ __forceinline__ float silu_f(float g) { return g * __builtin_amdgcn_rcpf(1.0f + __expf(-g)); }
__device__ __forceinline__ unsigned off_b(unsigned row, unsigned ch) { return 256u * row + 16u * (ch ^ (((row & 3u) << 2) | ((row >> 2) & 3u))); }
__device__ __forceinline__ unsigned tr_addr16(unsigned lane, unsigned c, unsigned ks, unsigned t) {
    const unsigned g = lane >> 4, q = (lane & 15u) >> 2, p = lane & 3u;
    return off_b(32u * ks + 8u * g + 4u * t + q, 2u * c + (p >> 1)) + 8u * (p & 1u);
}
__device__ __forceinline__ bf16x8 tr_read2(unsigned a0, unsigned a1) {
    const s16x4 lo = __builtin_amdgcn_ds_read_tr16_b64_v4i16((LAS s16x4*)a0), hi = __builtin_amdgcn_ds_read_tr16_b64_v4i16((LAS s16x4*)a1);
    bf16x8 r; r[0] = lo[0]; r[1] = lo[1]; r[2] = lo[2]; r[3] = lo[3]; r[4] = hi[0]; r[5] = hi[1]; r[6] = hi[2]; r[7] = hi[3]; return r;
}
template <int CTRL> __device__ __forceinline__ float dpp_f(float x) { return __int_as_float(__builtin_amdgcn_update_dpp(__float_as_int(x), __float_as_int(x), CTRL, 0xF, 0xF, false)); }
__device__ __forceinline__ float row16_sum(float s) { s += dpp_f<0xB1>(s); s += dpp_f<0x4E>(s); s += dpp_f<0x124>(s); s += dpp_f<0x128>(s); return s; }
__device__ __forceinline__ float xrow16_sum(float x) {
    auto s_ = __builtin_amdgcn_permlane16_swap(__float_as_uint(x), __float_as_uint(x), false, false); x = __uint_as_float(s_[0]) + __uint_as_float(s_[1]);
    auto t_ = __builtin_amdgcn_permlane32_swap(__float_as_uint(x), __float_as_uint(x), false, false); return __uint_as_float(t_[0]) + __uint_as_float(t_[1]); }
__device__ __forceinline__ float xrow16_max(float x) {
    auto s_ = __builtin_amdgcn_permlane16_swap(__float_as_uint(x), __float_as_uint(x), false, false); x = fmaxf(__uint_as_float(s_[0]), __uint_as_float(s_[1]));
    auto t_ = __builtin_amdgcn_permlane32_swap(__float_as_uint(x), __float_as_uint(x), false, false); return fmaxf(__uint_as_float(t_[0]), __uint_as_float(t_[1])); }
__device__ __forceinline__ float wave_sum(float x) { return xrow16_sum(row16_sum(x)); }
__device__ __forceinline__ float lane_xor32(float x, bool lower_half) {
    auto t_ = __builtin_amdgcn_permlane32_swap(__float_as_uint(x), __float_as_uint(x), false, false); return lower_half ? __uint_as_float(t_[1]) : __uint_as_float(t_[0]); }
__device__ __forceinline__ u32x4 pack8(const float (&v)[8]) { u32x4 w; w.x = cvt_pk_bf16(v[0], v[1]); w.y = cvt_pk_bf16(v[2], v[3]); w.z = cvt_pk_bf16(v[4], v[5]); w.w = cvt_pk_bf16(v[6], v[7]); return w; }
__device__ __forceinline__ void unpack8(u32x4 w, float (&v)[8]) { v[0] = bf_lo(w.x); v[1] = bf_hi(w.x); v[2] = bf_lo(w.y); v[3] = bf_hi(w.y); v[4] = bf_lo(w.z); v[5] = bf_hi(w.z); v[6] = bf_lo(w.w); v[7] = bf_hi(w.w); }

namespace pg8 {
#define PG8_LAS __attribute__((address_space(3)))
constexpr int BM = 256, BK = 64, HALF = 128, HTB = HALF * BK * 2, STAGE_BYTES = 8 * HTB, NXCD = 8, WGM = 8;
__device__ __forceinline__ int lds_byte(int r, int c) { const int st = (r >> 4) * 2 + (c >> 5), rr = r & 15, cc = c & 31, ob = rr * 64 + cc * 2; return st * 1024 + (ob ^ (((ob >> 9) & 1) << 5)); }
__device__ __forceinline__ void stage_rc(int b, int& R, int& C) { const int st = b / 1024, sb = b % 1024, swz = sb ^ (((sb >> 9) & 1) << 5); R = (st >> 1) * 16 + swz / 64; C = (st & 1) * 32 + (swz % 64) / 2; }
__device__ __forceinline__ int perm32(int rho) { const int n = rho >> 4, i = rho & 15; return 8 * (i >> 2) + 4 * n + (i & 3); }
struct Unit { int pm, pn; };
struct Gemm { const bf16_t* A; const bf16_t* Bt; int M, N, K, lda, ldb, agrp, bgrp; };
struct StaticOrder {
    int nM, nN, nwg, G, c;
    __device__ void init(int M, int N, int G_, int c_) { nM = M / BM; nN = N / BM; nwg = nM * nN; G = G_; c = c_; }
    __device__ bool next(int i, Unit& u) const {
        const long L = (long)i * G + c; if (L >= nwg) return false;
        int wgid = (int)L; { const int q = nwg / NXCD, r = nwg % NXCD, xcd = wgid % NXCD, off = wgid / NXCD; wgid = (xcd < r ? xcd * (q + 1) : r * (q + 1) + (xcd - r) * q) + off; }
        const int nig = WGM * nN, gid = wgid / nig, fm = gid * WGM, gsz = (nM - fm) < WGM ? (nM - fm) : WGM;
        u.pm = fm + ((wgid % nig) % gsz); u.pn = (wgid % nig) / gsz; return true;
    }
};

template <class Epi>
__device__ __forceinline__ void gemm_phase(const int tid, PG8_LAS unsigned char* lds, const Gemm g, const StaticOrder& S, const Epi& E) {
    const int wid = __builtin_amdgcn_readfirstlane(tid >> 6), lane = tid & 63, wr = wid >> 2, wc = wid & 3, fr = lane & 15, fq = lane >> 4;
    const int K = g.K, nt = K / BK;
    unsigned voffA[2], voffB[2];
#pragma unroll
    for (int i = 0; i < 2; ++i) { int R, C; stage_rc(tid * 16 + i * 8192, R, C); const int Rb = Epi::PERM ? ((R & ~31) + perm32(R & 31)) : R;
        voffA[i] = (unsigned)(R * g.lda + C) * 2u; voffB[i] = (unsigned)(Rb * g.ldb + C) * 2u; }
    const size_t kstep = (size_t)(BK * 2);
    const size_t hstepA = (size_t)HALF * g.lda * 2, hstepB = (size_t)HALF * g.ldb * 2;
    const size_t tstepA = 2 * hstepA, tstepB = 2 * hstepB;
    const unsigned ldsw = (unsigned)wid * 1024u;
    const int aoff = lds_byte(wr * 64 + fr, fq * 8), boff = lds_byte(wc * 32 + fr, fq * 8);
#define PG8_SA(b, h) (((b) * 2 + (h)) * HTB)
#define PG8_SB(b, h) ((4 + (b) * 2 + (h)) * HTB)
#define PG8_STAGE(bufoff, gbase, voff) do { _Pragma("unroll") for (int _i = 0; _i < 2; ++_i) \
        __builtin_amdgcn_global_load_lds((const unsigned*)((const char*)(gbase) + (voff)[_i]), (PG8_LAS unsigned*)(lds + (bufoff) + ldsw + _i * 8192), 16, 0, 0); } while (0)
#define PG8_LDA(dst, b, h) do { _Pragma("unroll") for (int m = 0; m < 4; ++m) _Pragma("unroll") for (int k = 0; k < 2; ++k) dst[m][k] = *(const PG8_LAS bf16x8*)(lds + PG8_SA(b, h) + aoff + m * 2048 + k * 1024); } while (0)
#define PG8_LDB(dst, b, h) do { _Pragma("unroll") for (int n = 0; n < 2; ++n) _Pragma("unroll") for (int k = 0; k < 2; ++k) dst[n][k] = *(const PG8_LAS bf16x8*)(lds + PG8_SB(b, h) + boff + n * 2048 + k * 1024); } while (0)
#define PG8_MMA(ai, bj, At, Bt) do { __builtin_amdgcn_s_setprio(1); _Pragma("unroll") for (int m = 0; m < 4; ++m) _Pragma("unroll") for (int n = 0; n < 2; ++n) _Pragma("unroll") for (int k = 0; k < 2; ++k) \
        acc[ai][bj][m][n] = __builtin_amdgcn_mfma_f32_16x16x32_bf16(Bt[n][k], At[m][k], acc[ai][bj][m][n], 0, 0, 0); __builtin_amdgcn_s_setprio(0); } while (0)
#define PG8_WAIT_V(n) asm volatile("s_waitcnt vmcnt(" #n ")" ::: "memory")
#define PG8_WAIT_L(n) asm volatile("s_waitcnt lgkmcnt(" #n ")" ::: "memory")
#define PG8_BAR __builtin_amdgcn_s_barrier()
#define PG8_SCHED __builtin_amdgcn_sched_barrier(0)
#define PG8_ABASE(u) ((const char*)g.A + (size_t)(u).pm * tstepA + (g.agrp ? (size_t)((u).pn / g.agrp) * (size_t)K * 2 : (size_t)0))
#define PG8_BBASE(u) ((const char*)g.Bt + (size_t)(u).pn * tstepB + (g.bgrp ? (size_t)((u).pm / g.bgrp) * (size_t)K * 2 : (size_t)0))
    Unit cur, nxt; int ui = 0;
    if (!S.next(0, cur)) return;
    f32x4 acc[2][2][4][2];
#pragma unroll
    for (int a = 0; a < 2; ++a)
#pragma unroll
        for (int b = 0; b < 2; ++b)
#pragma unroll
            for (int m = 0; m < 4; ++m)
#pragma unroll
                for (int n = 0; n < 2; ++n) acc[a][b][m][n] = (f32x4){0.f, 0.f, 0.f, 0.f};
    bf16x8 At[4][2], B0[2][2], B1[2][2];
    const char* cA = PG8_ABASE(cur); const char* cB = PG8_BBASE(cur);
    PG8_STAGE(PG8_SB(0, 0), cB, voffB); PG8_STAGE(PG8_SA(0, 0), cA, voffA); PG8_STAGE(PG8_SB(0, 1), cB + hstepB, voffB); PG8_STAGE(PG8_SA(0, 1), cA + hstepA, voffA);
    if (wr == 1) PG8_BAR;
    PG8_WAIT_V(4); PG8_BAR;
    PG8_STAGE(PG8_SB(1, 0), cB + kstep, voffB); PG8_STAGE(PG8_SA(1, 0), cA + kstep, voffA); PG8_STAGE(PG8_SB(1, 1), cB + hstepB + kstep, voffB);
    PG8_WAIT_V(6); PG8_BAR;
    for (;;) {
        const bool has_next = S.next(ui + 1, nxt);
        const char* nA = has_next ? PG8_ABASE(nxt) : cA; const char* nB = has_next ? PG8_BBASE(nxt) : cB;
        for (int t = 0; t < nt; t += 2) {
            const bool last = (t == nt - 2);
            const char* a1 = cA + (size_t)(t + 1) * kstep;
            const char* a2 = last ? nA : cA + (size_t)(t + 2) * kstep; const char* b2 = last ? nB : cB + (size_t)(t + 2) * kstep;
            const char* a3 = a2 + kstep; const char* b3 = b2 + kstep;
            PG8_LDB(B0, 0, 0); PG8_SCHED; PG8_LDA(At, 0, 0); PG8_STAGE(PG8_SA(1, 1), a1 + hstepA, voffA);
            PG8_WAIT_L(8); PG8_BAR; PG8_WAIT_L(0); PG8_MMA(0, 0, At, B0); PG8_BAR; PG8_SCHED;
            PG8_LDB(B1, 0, 1); PG8_STAGE(PG8_SB(0, 0), b2, voffB);
            PG8_BAR; PG8_WAIT_L(0); PG8_MMA(0, 1, At, B1); PG8_BAR;
            PG8_LDA(At, 0, 1); PG8_STAGE(PG8_SA(0, 0), a2, voffA);
            PG8_BAR; PG8_WAIT_L(0); PG8_MMA(1, 0, At, B0); PG8_BAR; PG8_SCHED;
            PG8_STAGE(PG8_SB(0, 1), b2 + hstepB, voffB);
            PG8_WAIT_V(6); PG8_BAR; PG8_MMA(1, 1, At, B1); PG8_BAR;
            PG8_LDB(B0, 1, 0); PG8_SCHED; PG8_LDA(At, 1, 0); PG8_STAGE(PG8_SA(0, 1), a2 + hstepA, voffA);
            PG8_WAIT_L(8); PG8_BAR; PG8_WAIT_L(0); PG8_MMA(0, 0, At, B0); PG8_BAR; PG8_SCHED;
            PG8_LDB(B1, 1, 1); PG8_STAGE(PG8_SB(1, 0), b3, voffB);
            PG8_BAR; PG8_WAIT_L(0); PG8_MMA(0, 1, At, B1); PG8_BAR;
            PG8_LDA(At, 1, 1); PG8_STAGE(PG8_SA(1, 0), a3, voffA);
            PG8_BAR; PG8_WAIT_L(0); PG8_MMA(1, 0, At, B0); PG8_BAR; PG8_SCHED;
            PG8_STAGE(PG8_SB(1, 1), b3 + hstepB, voffB);
            PG8_WAIT_V(6); PG8_BAR; PG8_MMA(1, 1, At, B1); PG8_BAR;
        }
        E(acc, cur, wr, wc, fr, fq);
        if (!has_next) break;
#pragma unroll
        for (int a = 0; a < 2; ++a)
#pragma unroll
            for (int b = 0; b < 2; ++b)
#pragma unroll
                for (int m = 0; m < 4; ++m)
#pragma unroll
                    for (int n = 0; n < 2; ++n) acc[a][b][m][n] = (f32x4){0.f, 0.f, 0.f, 0.f};
        cur = nxt; cA = nA; cB = nB; ++ui;
    }
    PG8_WAIT_V(0);
    if (wr == 0) PG8_BAR;
    PG8_BAR;
#undef PG8_SA
#undef PG8_SB
#undef PG8_STAGE
#undef PG8_LDA
#undef PG8_LDB
#undef PG8_MMA
#undef PG8_WAIT_V
#undef PG8_WAIT_L
#undef PG8_BAR
#undef PG8_SCHED
#undef PG8_ABASE
#undef PG8_BBASE
}

struct EpiStore {
    static constexpr bool PERM = true;
    bf16_t* O; int ldc;
    __device__ __forceinline__ void operator()(const f32x4 (&acc)[2][2][4][2], const Unit& u, int wr, int wc, int fr, int fq) const {
        const int row0 = u.pm * BM + wr * 64 + fr, col0 = u.pn * BM + wc * 32 + 8 * fq;
#pragma unroll
        for (int ai = 0; ai < 2; ++ai)
#pragma unroll
            for (int m = 0; m < 4; ++m) { bf16_t* rowp = O + (size_t)(row0 + ai * HALF + m * 16) * ldc + col0;
#pragma unroll
                for (int bj = 0; bj < 2; ++bj) { const f32x4 v0 = acc[ai][bj][m][0], v1 = acc[ai][bj][m][1];
                    u32x4 w; w.x = cvt_pk_bf16(v0[0], v0[1]); w.y = cvt_pk_bf16(v0[2], v0[3]); w.z = cvt_pk_bf16(v1[0], v1[1]); w.w = cvt_pk_bf16(v1[2], v1[3]);
                    *(u32x4*)(rowp + bj * HALF) = w; } }
    }
};
struct EpiResid {
    static constexpr bool PERM = false;
    const float* base; float* out;
    __device__ __forceinline__ void operator()(const f32x4 (&acc)[2][2][4][2], const Unit& u, int wr, int wc, int fr, int fq) const {
        const int row0 = u.pm * BM + wr * 64 + fr, col0 = u.pn * BM + wc * 32 + 4 * fq;
        f32x4 bs[2][2][2][2];
#define ER_LOAD(Q, BUF) { _Pragma("unroll") for (int mm = 0; mm < 2; ++mm) { const size_t off = (size_t)(row0 + ((Q) >> 1) * HALF + (2 * ((Q) & 1) + mm) * 16) * 1024 + col0; \
            _Pragma("unroll") for (int bj = 0; bj < 2; ++bj) _Pragma("unroll") for (int n = 0; n < 2; ++n) bs[BUF][mm][bj][n] = *(const f32x4*)(base + off + bj * HALF + n * 16); } }
#define ER_STORE(Q, BUF) { _Pragma("unroll") for (int mm = 0; mm < 2; ++mm) { const size_t off = (size_t)(row0 + ((Q) >> 1) * HALF + (2 * ((Q) & 1) + mm) * 16) * 1024 + col0; \
            _Pragma("unroll") for (int bj = 0; bj < 2; ++bj) _Pragma("unroll") for (int n = 0; n < 2; ++n) *(f32x4*)(out + off + bj * HALF + n * 16) = bs[BUF][mm][bj][n] + acc[(Q) >> 1][bj][2 * ((Q) & 1) + mm][n]; } }
        ER_LOAD(0, 0) ER_LOAD(1, 1) ER_STORE(0, 0) ER_LOAD(2, 0) ER_STORE(1, 1) ER_LOAD(3, 1) ER_STORE(2, 0) ER_STORE(3, 1)
#undef ER_LOAD
#undef ER_STORE
    }
};
struct EpiRet {
    static constexpr bool PERM = true;
    bf16_t* O; const float* cosT; const float* sinT;
    __device__ __forceinline__ void operator()(const f32x4 (&acc)[2][2][4][2], const Unit& u, int wr, int wc, int fr, int fq) const {
        const int row0 = u.pm * BM + wr * 64 + fr, col0 = u.pn * BM + wc * 32 + 8 * fq;
        const bool rot = u.pn < 16; const float ksc = ((u.pn >> 2) & 1) ? 0.0625f : 1.0f;
        const int tcol = wc * 32 + 8 * fq;
        f32x4 cb[2][2], sb[2][2], cd[2], sd[2];
        if (rot) {
#pragma unroll
            for (int hh = 0; hh < 2; ++hh) { cd[hh] = *(const f32x4*)(cosT + 16 * 128 + tcol + 4 * hh); sd[hh] = *(const f32x4*)(sinT + 16 * 128 + tcol + 4 * hh);
#pragma unroll
                for (int ai = 0; ai < 2; ++ai) { const int ti = ((row0 + ai * HALF) & 4095) * 128 + tcol + 4 * hh; cb[ai][hh] = *(const f32x4*)(cosT + ti); sb[ai][hh] = *(const f32x4*)(sinT + ti); } }
        }
#pragma unroll
        for (int ai = 0; ai < 2; ++ai) {
            f32x4 c0 = cb[ai][0], c1 = cb[ai][1], s0 = sb[ai][0], s1 = sb[ai][1];
#pragma unroll
            for (int m = 0; m < 4; ++m) { const int row = row0 + ai * HALF + m * 16; bf16_t* rowp = O + (size_t)row * 8192 + col0;
                f32x4 a0 = acc[ai][0][m][0], a1 = acc[ai][0][m][1], b0 = acc[ai][1][m][0], b1 = acc[ai][1][m][1];
                if (rot) {
                    const f32x4 o0 = (a0 * c0 - b0 * s0) * ksc, o1 = (a1 * c1 - b1 * s1) * ksc, p0 = (b0 * c0 + a0 * s0) * ksc, p1 = (b1 * c1 + a1 * s1) * ksc;
                    a0 = o0; a1 = o1; b0 = p0; b1 = p1;
                    const f32x4 nc0 = c0 * cd[0] - s0 * sd[0], ns0 = s0 * cd[0] + c0 * sd[0], nc1 = c1 * cd[1] - s1 * sd[1], ns1 = s1 * cd[1] + c1 * sd[1];
                    c0 = nc0; s0 = ns0; c1 = nc1; s1 = ns1; }
                u32x4 w; w.x = cvt_pk_bf16(a0[0], a0[1]); w.y = cvt_pk_bf16(a0[2], a0[3]); w.z = cvt_pk_bf16(a1[0], a1[1]); w.w = cvt_pk_bf16(a1[2], a1[3]);
                *(u32x4*)(rowp) = w;
                w.x = cvt_pk_bf16(b0[0], b0[1]); w.y = cvt_pk_bf16(b0[2], b0[3]); w.z = cvt_pk_bf16(b1[0], b1[1]); w.w = cvt_pk_bf16(b1[2], b1[3]);
                *(u32x4*)(rowp + HALF) = w; }
        }
    }
};
}

template <class Epi>
__device__ __forceinline__ void run_gemm(const int tid, LAS unsigned char* lds, const bf16_t* A, int lda, const bf16_t* Bt, int ldb, int M, int N, int K, int agrp, const Epi& E, int bgrp = 0) {
    pg8::Gemm g; g.A = A; g.Bt = Bt; g.M = M; g.N = N; g.K = K; g.lda = lda; g.ldb = ldb; g.agrp = agrp; g.bgrp = bgrp;
    pg8::StaticOrder S; S.init(M, N, (int)gridDim.x, (int)blockIdx.x);
    pg8::gemm_phase<Epi>(tid, lds, g, S, E);
}

__device__ __forceinline__ void transpose_batch(const int tid, LAS unsigned char* lds, const float* src, bf16_t* dst, int K, int N, int batch, int src_ld = 0, size_t src_bs = 0, size_t dst_bs = 0) {
    LAS float* tile = (LAS float*)lds;
    if (src_ld == 0) src_ld = N; if (src_bs == 0) src_bs = (size_t)K * N; if (dst_bs == 0) dst_bs = (size_t)K * N;
    const int ntk = K / 64, ntn = N / 64, per = ntk * ntn, total = batch * per;
    for (int t = blockIdx.x; t < total; t += gridDim.x) {
        const int bt = t / per, rem = t - bt * per, tk = rem / ntn, tn = rem - tk * ntn;
        const float* s = src + (size_t)bt * src_bs + (size_t)(tk * 64) * src_ld + tn * 64;
        bf16_t* d = dst + (size_t)bt * dst_bs + (size_t)(tn * 64) * K + tk * 64;
#pragma unroll
        for (int i = 0; i < 8; ++i) { const int k = (tid >> 6) + 8 * i, n = tid & 63; tile[k * 65 + n] = s[(size_t)k * src_ld + n]; }
        __syncthreads();
#pragma unroll
        for (int i = 0; i < 8; ++i) { const int n = (tid >> 6) + 8 * i, k = tid & 63; const float v = tile[k * 65 + n]; d[(size_t)n * K + k] = (bf16_t)(cvt_pk_bf16(v, v) & 0xffffu); }
        __syncthreads();
    }
}
__device__ __forceinline__ void convert_rows(const int tid, const float* src, bf16_t* dst, int rows, int ncols, int src_ld) {
    const int per_row = ncols / 4, total = rows * per_row;
    for (int e = blockIdx.x * 512 + tid; e < total; e += gridDim.x * 512) { const int r = e / per_row, c4 = e - r * per_row;
        const f32x4 v = *(const f32x4*)(src + (size_t)r * src_ld + c4 * 4); u32x2 w; w.x = cvt_pk_bf16(v[0], v[1]); w.y = cvt_pk_bf16(v[2], v[3]); *(u32x2*)(dst + (size_t)r * ncols + c4 * 4) = w; }
}
__device__ __forceinline__ void sincos_d(double x, float& s, float& c) {
    const double q = rint(x * 0.63661977236758134308);
    const double r = (x - q * 1.57079632679489655800) - q * 6.12323399573676603587e-17;
    const double r2 = r * r;
    double sp = 1.0 / 6227020800.0; sp = sp * r2 - 1.0 / 39916800.0; sp = sp * r2 + 1.0 / 362880.0; sp = sp * r2 - 1.0 / 5040.0; sp = sp * r2 + 1.0 / 120.0; sp = sp * r2 - 1.0 / 6.0; sp = sp * r2 + 1.0; sp = sp * r;
    double cp = -1.0 / 87178291200.0; cp = cp * r2 + 1.0 / 479001600.0; cp = cp * r2 - 1.0 / 3628800.0; cp = cp * r2 + 1.0 / 40320.0; cp = cp * r2 - 1.0 / 720.0; cp = cp * r2 + 1.0 / 24.0; cp = cp * r2 - 0.5; cp = cp * r2 + 1.0;
    const int qi = ((int)q) & 3;
    const double ss = (qi == 0) ? sp : (qi == 1) ? cp : (qi == 2) ? -sp : -cp;
    const double cc = (qi == 0) ? cp : (qi == 1) ? -sp : (qi == 2) ? -cp : sp;
    s = (float)ss; c = (float)cc;
}
__device__ __forceinline__ void rope_tables(const int tid, float* rc, float* rs, float* ac, float* as) {
    const int gt = blockIdx.x * 512 + tid, gs = gridDim.x * 512;
    for (int e = gt; e < 4096 * 128; e += gs) { const int pos = e >> 7, i = e & 127;
        const float inv = (float)exp2(-13.287712379549449 * ((double)i / 128.0));
        const float ang = (float)pos * inv; float s, c; sincos_d((double)ang, s, c); rc[e] = c; rs[e] = s; }
    for (int e = gt; e < 4096 * 16; e += gs) { const int pos = e >> 4, i = e & 15;
        const float inv = (float)exp2(-18.931568569324174 * ((double)i / 16.0));
        const float ang = (float)pos * inv; float s, c; sincos_d((double)ang, s, c); ac[e] = c; as[e] = s; }
}

__device__ __forceinline__ void rmsnorm_phase(const int tid, const float* x, const float* w, bf16_t* h) {
    const int lane = tid & 63, gw = blockIdx.x * 8 + (tid >> 6), nw = gridDim.x * 8;
    f32x4 wv[4];
#pragma unroll
    for (int i = 0; i < 4; ++i) wv[i] = ((const f32x4*)w)[lane + 64 * i];
    if ((MH % (2 * nw)) != 0) return;
    for (int row = gw; row < MH; row += 2 * nw) {
        f32x4 v[2][4]; float ss[2];
#pragma unroll
        for (int r2 = 0; r2 < 2; ++r2) { const f32x4* xp = (const f32x4*)(x + (size_t)(row + r2 * nw) * 1024);
#pragma unroll
            for (int i = 0; i < 4; ++i) v[r2][i] = xp[lane + 64 * i]; }
#pragma unroll
        for (int r2 = 0; r2 < 2; ++r2) { float a = 0.f;
#pragma unroll
            for (int i = 0; i < 4; ++i) a += v[r2][i][0] * v[r2][i][0] + v[r2][i][1] * v[r2][i][1] + v[r2][i][2] * v[r2][i][2] + v[r2][i][3] * v[r2][i][3];
            ss[r2] = wave_sum(a); }
#pragma unroll
        for (int r2 = 0; r2 < 2; ++r2) { const float rstd = __builtin_amdgcn_rsqf(ss[r2] * (1.0f / 1024.0f) + EPS);
#pragma unroll
            for (int i = 0; i < 4; ++i) { const f32x4 o = v[r2][i] * rstd * wv[i]; u32x2 pk; pk.x = cvt_pk_bf16(o[0], o[1]); pk.y = cvt_pk_bf16(o[2], o[3]);
                *(u32x2*)(h + (size_t)(row + r2 * nw) * 1024 + 4 * (lane + 64 * i)) = pk; } }
    }
}

template <int H>
__device__ __forceinline__ void pool_mix_run(const bf16_t* ub, bf16_t* db, const float (&sc)[8], const int s0) {
    u32x4 ring[2 * H]; float sum[8];
#pragma unroll
    for (int e = 0; e < 8; ++e) sum[e] = 0.f;
#pragma unroll
    for (int k = 0; k < 2 * H; ++k) { const int rr = s0 - H + k; ring[k] = (u32x4){0u, 0u, 0u, 0u};
        if (rr >= 0 && rr < SEQ) ring[k] = *(const u32x4*)(ub + (size_t)rr * 4096);
        float v[8]; unpack8(ring[k], v);
#pragma unroll
        for (int e = 0; e < 8; ++e) sum[e] += v[e]; }
    for (int sb = s0; sb < s0 + 64; sb += 2 * H) {
#pragma unroll
        for (int t = 0; t < 2 * H; ++t) {
            const int s = sb + t;
            const int lo = (s - H) > 0 ? (s - H) : 0, hi = (s + H) < SEQ ? (s + H) : SEQ;
            const float inv = __builtin_amdgcn_rcpf((float)(hi - lo));
            const u32x4 gw = *(const u32x4*)(ub + (size_t)s * 4096 + 2048);
            u32x4 nw = (u32x4){0u, 0u, 0u, 0u}; if (s + H < SEQ) nw = *(const u32x4*)(ub + (size_t)(s + H) * 4096);
            float cv[8], gv[8], o[8], av[8], bv[8]; unpack8(ring[(t + H) % (2 * H)], cv); unpack8(gw, gv); unpack8(nw, av); unpack8(ring[t], bv);
#pragma unroll
            for (int e = 0; e < 8; ++e) { const float d = sum[e] * inv - cv[e]; o[e] = d * sc[e] * silu_f(gv[e]); }
            *(u32x4*)(db + (size_t)s * 2048) = pack8(o);
#pragma unroll
            for (int e = 0; e < 8; ++e) sum[e] += av[e] - bv[e];
            ring[t] = nw;
        }
    }
}
__device__ __forceinline__ void pool_mix_phase(const int tid, const bf16_t* mg, const float* scale, bf16_t* y) {
    const int total = HB * 64 * 256;
    for (int id = blockIdx.x * 512 + tid; id < total; id += gridDim.x * 512) {
        const int chunk = id & 255, run = (id >> 8) & 63, b = id >> 14;
        const int g = chunk >> 6;
        const bf16_t* ub = mg + (size_t)(b * SEQ) * 4096 + chunk * 8;
        bf16_t* db = y + (size_t)(b * SEQ) * 2048 + chunk * 8;
        const f32x4 sc0 = *(const f32x4*)(scale + chunk * 8), sc1 = *(const f32x4*)(scale + chunk * 8 + 4);
        const float sc[8] = {sc0[0], sc0[1], sc0[2], sc0[3], sc1[0], sc1[1], sc1[2], sc1[3]};
        const int s0 = run * 64;
        if (g == 0) pool_mix_run<1>(ub, db, sc, s0); else if (g == 1) pool_mix_run<2>(ub, db, sc, s0); else if (g == 2) pool_mix_run<4>(ub, db, sc, s0); else pool_mix_run<8>(ub, db, sc, s0);
    }
}

struct AttItem { int b, g, head, r, n0, dsh; };
__device__ __forceinline__ AttItem att_decode(int item) {
    AttItem it; const int pairidx = item & 31; it.head = (item >> 5) & 7; const int bg = item >> 8; it.g = bg % 3; it.b = bg / 3;
    it.dsh = 2 * it.g; const int ppr = 32 >> it.dsh; it.r = pairidx / ppr; it.n0 = 2 * (pairidx - it.r * ppr); return it;
}
__device__ __forceinline__ void att_load_half(const AttItem& it, const int tid, const bf16_t* proj, const float* cosT, const float* sinT, const int I0,
                                              u32x4 (&kvs)[4], u32x4 (&vvs)[4], f32x4 (&kct)[2], f32x4 (&kst)[2]) {
    const int ch = tid & 15, rowb = tid >> 4, dil = 1 << it.dsh, nsub = 4096 >> it.dsh;
    const bf16_t* base = proj + (size_t)(it.b * SEQ) * 10240 + it.g * 3072 + it.head * 128;
#pragma unroll
    for (int i4 = 0; i4 < 4; ++i4) {
        const int jk = (it.n0 - 1) * 64 + rowb + 32 * (I0 + i4); const bool valid = (jk >= 0) && (jk < nsub);
        kvs[i4] = (u32x4){0u, 0u, 0u, 0u}; vvs[i4] = (u32x4){0u, 0u, 0u, 0u};
        if (valid) { const bf16_t* p = base + (size_t)(jk * dil + it.r) * 10240; kvs[i4] = *(const u32x4*)(p + 1024 + ch * 8); vvs[i4] = *(const u32x4*)(p + 2048 + ch * 8); }
    }
    const int pb = ((it.n0 - 1) * 64 + rowb + 32 * I0) * dil + it.r, pa = pb < 0 ? -pb : pb;
#pragma unroll
    for (int hh = 0; hh < 2; ++hh) { kct[hh] = *(const f32x4*)(cosT + pa * 16 + (ch & 1) * 8 + 4 * hh); kst[hh] = *(const f32x4*)(sinT + pa * 16 + (ch & 1) * 8 + 4 * hh); }
}
__device__ __forceinline__ void att_load_q(const AttItem& it, const int tid, const bf16_t* proj, u32x4 (&qraw)[4]) {
    const int dil = 1 << it.dsh, lane = tid & 63, fr = lane & 15, fq = lane >> 4, ql = (tid >> 6) * 16 + fr, posq = (it.n0 * 64 + ql) * dil + it.r;
    const bf16_t* qp = proj + (size_t)(it.b * SEQ) * 10240 + it.g * 3072 + it.head * 128 + (size_t)posq * 10240;
#pragma unroll
    for (int s = 0; s < 4; ++s) qraw[s] = *(const u32x4*)(qp + 32 * s + 8 * fq);
}

__device__ __forceinline__ void attn_phase(const int tid_in, LAS unsigned char* lds, bf16_t* proj, float* lse, const float* qn, const float* kn, const float* cosT, const float* sinT) {
    LAS unsigned char* Kimg = lds; LAS unsigned char* Vimg = lds + 65536;
    const int nitems = HB * 3 * 8 * 32;
    LAS float* gq = (LAS float*)(lds + 131072); LAS float* gk = gq + 384; LAS float* dtab = gk + 384;
    if (tid_in < 384) { gq[tid_in] = qn[tid_in]; gk[tid_in] = kn[tid_in]; }
    if (tid_in < 96) { const int gg = tid_in >> 5, i = tid_in & 31; dtab[tid_in] = (i < 16) ? cosT[(32 << (2 * gg)) * 16 + i] : sinT[(32 << (2 * gg)) * 16 + (i - 16)]; }
    __syncthreads();
    const int tid = tid_in, w = tid >> 6, lane = tid & 63, fr = lane & 15, fq = lane >> 4;
    LAS const unsigned char* kbase[2][4]; LAS const unsigned char* vb2[2]; unsigned xe2[2];
#pragma unroll
    for (int h = 0; h < 2; ++h)
#pragma unroll
        for (int s = 0; s < 4; ++s) kbase[h][s] = Kimg + off_b(8 * (fr >> 2) + 4 * h + (fr & 3), 4 * s + fq);
#pragma unroll
    for (int t = 0; t < 2; ++t) { const unsigned q = (lane & 15) >> 2, p = lane & 3, Xt = (q << 2) | ((2 * fq + t) & 3);
        vb2[t] = Vimg + 256 * (8 * fq + 4 * t + q) + 16 * ((p >> 1) ^ (Xt & 1)) + 8 * (p & 1); xe2[t] = Xt >> 1; }
    const int per_blk = (nitems + (int)gridDim.x - 1) / (int)gridDim.x, item_lo = (int)blockIdx.x * per_blk, item_hi = (item_lo + per_blk) < nitems ? (item_lo + per_blk) : nitems;
    for (int item = item_lo; item < item_hi; ++item) {
        const AttItem it = att_decode(item);
        const int head = it.head, g = it.g, b = it.b, r = it.r, n0 = it.n0, dsh = it.dsh, dil = 1 << dsh, nsub = 4096 >> dsh;
        const bool cont = (item > item_lo) && (n0 != 0);
        u32x4 kvs[4], vvs[4], qraw[4]; f32x4 kct[2], kst[2];
        att_load_q(it, tid, proj, qraw);
        att_load_half(it, tid, proj, cosT, sinT, 4, kvs, vvs, kct, kst);
        const int p0 = __builtin_amdgcn_readfirstlane((n0 - 1 + (w >> 2)) & 3);
        const int offj[3] = {16384 * p0, 16384 * ((p0 + 1) & 3), 16384 * ((p0 + 2) & 3)};
        bf16_t* base = proj + (size_t)(b * SEQ) * 10240 + g * 3072 + head * 128;
        const int ch = tid & 15, rowb = tid >> 4;
        const int ql = w * 16 + fr, jq = n0 * 64 + ql, posq = jq * dil + r;
        bf16_t* qp = base + (size_t)posq * 10240;
        const int pbase = ((n0 - 1) * 64 + rowb) * dil + r, pabs = pbase < 0 ? -pbase : pbase;
        f32x4 wkv[2], kcd[2], ksd[2], qc[2], qs[2];
#pragma unroll
        for (int hh = 0; hh < 2; ++hh) {
            qc[hh] = *(const f32x4*)(cosT + posq * 16 + (fq & 1) * 8 + 4 * hh); qs[hh] = *(const f32x4*)(sinT + posq * 16 + (fq & 1) * 8 + 4 * hh);
            wkv[hh] = *(const LAS f32x4*)(gk + g * 128 + ch * 8 + 4 * hh);
            kcd[hh] = *(const LAS f32x4*)(dtab + g * 32 + (ch & 1) * 8 + 4 * hh); ksd[hh] = *(const LAS f32x4*)(dtab + g * 32 + 16 + (ch & 1) * 8 + 4 * hh);
        }
        bf16x8 qfrag[4];
        {
            float qf[4][8]; float ss = 0.f;
#pragma unroll
            for (int s = 0; s < 4; ++s) { unpack8(qraw[s], qf[s]);
#pragma unroll
                for (int e = 0; e < 8; ++e) ss += qf[s][e] * qf[s][e]; }
            ss = xrow16_sum(ss);
            const float rstd = __builtin_amdgcn_rsqf(ss * (1.0f / 128.0f) + EPS);
#pragma unroll
            for (int s = 0; s < 4; ++s)
#pragma unroll
                for (int e = 0; e < 8; ++e) qf[s][e] = qf[s][e] * rstd * gq[g * 128 + 32 * s + 8 * fq + e];
#pragma unroll
            for (int e = 0; e < 8; ++e) { const float pr = lane_xor32(qf[0][e], fq < 2); const float c = qc[e >> 2][e & 3], sn = qs[e >> 2][e & 3];
                qf[0][e] = (fq < 2) ? (qf[0][e] * c - pr * sn) : (qf[0][e] * c + pr * sn); }
            const float sc = 0.08838834764831845f * 1.4426950408889634f;
#pragma unroll
            for (int s = 0; s < 4; ++s) {
#pragma unroll
                for (int e = 0; e < 8; ++e) qf[s][e] *= sc;
                qfrag[s] = __builtin_bit_cast(bf16x8, pack8(qf[s])); }
        }
#define ATT_STAGE_HALF(I0, CC0, SS0, NEG) { float cc[8], sn[8]; \
            _Pragma("unroll") for (int e = 0; e < 8; ++e) { cc[e] = CC0[e >> 2][e & 3]; sn[e] = (NEG) ? -SS0[e >> 2][e & 3] : SS0[e >> 2][e & 3]; } \
            _Pragma("unroll") for (int i = (I0); i < (I0) + 4; ++i) { \
                if ((i & 1) == 0) __builtin_amdgcn_sched_barrier(0); \
                const int slot = (n0 - 1 + (i >> 1)) & 3; \
                float x[8]; unpack8(kvs[i - (I0)], x); \
                float ss = 0.f; \
                _Pragma("unroll") for (int e = 0; e < 8; ++e) ss += x[e] * x[e]; \
                ss = row16_sum(ss); \
                const float rstd = __builtin_amdgcn_rsqf(ss * (1.0f / 128.0f) + EPS); \
                _Pragma("unroll") for (int e = 0; e < 8; ++e) x[e] = x[e] * rstd * wkv[e >> 2][e & 3]; \
                _Pragma("unroll") for (int e = 0; e < 8; ++e) { const float pr = dpp_f<0x4E>(x[e]); const float rot = (ch < 2) ? (x[e] * cc[e] - pr * sn[e]) : (x[e] * cc[e] + pr * sn[e]); x[e] = (ch < 4) ? rot : x[e]; } \
                *(LAS u32x4*)(Kimg + 16384 * slot + off_b(rowb + 32 * (i & 1), ch)) = pack8(x); \
                *(LAS u32x4*)(Vimg + 16384 * slot + off_b(rowb + 32 * (i & 1), ch)) = vvs[i - (I0)]; \
                _Pragma("unroll") for (int e = 0; e < 8; ++e) { const float cd = kcd[e >> 2][e & 3], sd = ksd[e >> 2][e & 3]; const float c2 = cc[e] * cd - sn[e] * sd, s2 = sn[e] * cd + cc[e] * sd; cc[e] = c2; sn[e] = s2; } } }
        ATT_STAGE_HALF(4, kct, kst, false)
        if (!cont) { att_load_half(it, tid, proj, cosT, sinT, 0, kvs, vvs, kct, kst); ATT_STAGE_HALF(0, kct, kst, pbase < 0) }
#undef ATT_STAGE_HALF
        __syncthreads();
        const int mskip = __builtin_amdgcn_readfirstlane(((w & 3) < 2) ? 5 : 0);
        f32x4 sacc[12];
#pragma unroll
        for (int tt = 0; tt < 12; ++tt) {
            if ((tt & 1) == 0) __builtin_amdgcn_sched_barrier(0);
            sacc[tt] = (f32x4){0.f, 0.f, 0.f, 0.f};
            if ((tt >> 1) != mskip)
#pragma unroll
            for (int s = 0; s < 4; ++s) { const bf16x8 kf = *(const LAS bf16x8*)(kbase[tt & 1][s] + offj[tt >> 2] + 8192 * ((tt >> 1) & 1)); sacc[tt] = mfma16(kf, qfrag[s], sacc[tt]); }
        }
        const int jkb = (n0 - 1) * 64 + (w >> 2) * 64, qlw = (w & 3) * 16 + fr;
        const int lo2 = (qlw > -jkb ? qlw : -jkb) - 8 * fq, hi2 = ((qlw + 128) < (nsub - 1 - jkb) ? (qlw + 128) : (nsub - 1 - jkb)) - 8 * fq;
        float mx = -3.0e38f;
#pragma unroll
        for (int tt = 0; tt < 12; ++tt)
#pragma unroll
            for (int j = 0; j < 4; ++j) { const int kc = 32 * (tt >> 1) + 4 * (tt & 1) + j;
                const bool ok = (kc >= lo2) && (kc <= hi2);
                const float v = ok ? sacc[tt][j] : -1.0e30f; sacc[tt][j] = v; mx = fmaxf(mx, v); }
        mx = xrow16_max(mx);
        float sum = 0.f;
#pragma unroll
        for (int tt = 0; tt < 12; ++tt)
#pragma unroll
            for (int j = 0; j < 4; ++j) { const float p = __builtin_amdgcn_exp2f(sacc[tt][j] - mx); sacc[tt][j] = p; sum += p; }
        sum = xrow16_sum(sum);
        bf16x8 pfrag[6];
#pragma unroll
        for (int m = 0; m < 6; ++m) { u32x4 pw; pw.x = cvt_pk_bf16(sacc[2 * m][0], sacc[2 * m][1]); pw.y = cvt_pk_bf16(sacc[2 * m][2], sacc[2 * m][3]);
            pw.z = cvt_pk_bf16(sacc[2 * m + 1][0], sacc[2 * m + 1][1]); pw.w = cvt_pk_bf16(sacc[2 * m + 1][2], sacc[2 * m + 1][3]); pfrag[m] = __builtin_bit_cast(bf16x8, pw); }
        f32x4 oacc[8];
#pragma unroll
        for (int c = 0; c < 8; ++c) oacc[c] = (f32x4){0.f, 0.f, 0.f, 0.f};
#pragma unroll
        for (int ks = 0; ks < 6; ++ks)
            if (ks != mskip)
#pragma unroll
            for (int c = 0; c < 8; ++c) {
                if ((c & 3) == 0) __builtin_amdgcn_sched_barrier(0);
                const s16x4 lo = __builtin_amdgcn_ds_read_tr16_b64_v4i16((LAS s16x4*)(vb2[0] + 32 * (c ^ xe2[0]) + offj[ks >> 1] + 8192 * (ks & 1))), hi = __builtin_amdgcn_ds_read_tr16_b64_v4i16((LAS s16x4*)(vb2[1] + 32 * (c ^ xe2[1]) + offj[ks >> 1] + 8192 * (ks & 1)));
                bf16x8 vf; vf[0] = lo[0]; vf[1] = lo[1]; vf[2] = lo[2]; vf[3] = lo[3]; vf[4] = hi[0]; vf[5] = hi[1]; vf[6] = hi[2]; vf[7] = hi[3];
                oacc[c] = mfma16(vf, pfrag[ks], oacc[c]); }
        const float inv = __builtin_amdgcn_rcpf(sum);
#pragma unroll
        for (int c = 0; c < 8; ++c) { const f32x4 o = oacc[c] * inv; u32x2 pw; pw.x = cvt_pk_bf16(o[0], o[1]); pw.y = cvt_pk_bf16(o[2], o[3]); *(u32x2*)(qp + 16 * c + 4 * fq) = pw; }
        if (fq == 0) lse[(size_t)(b * SEQ + posq) * 24 + g * 8 + head] = (mx + log2f(sum)) * 0.6931471805599453f;
        __syncthreads();
    }
}

__device__ __forceinline__ void attn_combine_phase(const int tid, bf16_t* proj, const float* lse) {
    const int lane = tid & 63, gw = blockIdx.x * 8 + (tid >> 6), nw = gridDim.x * 8;
    if (((MH * 2) % (2 * nw)) != 0) return;
    for (int task0 = gw; task0 < MH * 2; task0 += 2 * nw) {
        u32x4 ra[2], rb[2], rc[2], rg[2]; float l0[2], l1[2], l2[2];
#pragma unroll
        for (int t2 = 0; t2 < 2; ++t2) { const int task = task0 + t2 * nw, row = task >> 1, head = (task & 1) * 4 + (lane >> 4), d0 = (lane & 15) * 8;
            const bf16_t* p = proj + (size_t)row * 10240 + head * 128 + d0; const float* lp = lse + (size_t)row * 24 + head;
            ra[t2] = *(const u32x4*)(p); rb[t2] = *(const u32x4*)(p + 3072); rc[t2] = *(const u32x4*)(p + 6144); rg[t2] = *(const u32x4*)(proj + (size_t)row * 10240 + 9216 + head * 128 + d0);
            l0[t2] = lp[0]; l1[t2] = lp[8]; l2[t2] = lp[16]; }
#pragma unroll
        for (int t2 = 0; t2 < 2; ++t2) { const int task = task0 + t2 * nw, row = task >> 1, head = (task & 1) * 4 + (lane >> 4), d0 = (lane & 15) * 8;
            const float m = fmaxf(l0[t2], fmaxf(l1[t2], l2[t2]));
            float w0 = __expf(l0[t2] - m), w1 = __expf(l1[t2] - m), w2 = __expf(l2[t2] - m);
            const float inv = __builtin_amdgcn_rcpf(w0 + w1 + w2); w0 *= inv; w1 *= inv; w2 *= inv;
            float a[8], bq[8], c[8], gt[8], o[8];
            unpack8(ra[t2], a); unpack8(rb[t2], bq); unpack8(rc[t2], c); unpack8(rg[t2], gt);
#pragma unroll
            for (int e = 0; e < 8; ++e) { const float y = w0 * a[e] + w1 * bq[e] + w2 * c[e]; o[e] = y * silu_f(gt[e]); }
            *(u32x4*)(proj + (size_t)row * 10240 + head * 128 + d0) = pack8(o); }
    }
}

__device__ __forceinline__ void ret_chain_phase(int tid, LAS unsigned char* lds, const bf16_t* proj, bf16_t* outbuf, const float* decay) {
    const int w = tid >> 6, lane = tid & 63, fr = lane & 15, fq = lane >> 4;
    LAS unsigned char* R1 = lds; LAS unsigned char* RV = lds + 65536;
    for (int item = blockIdx.x; item < HB * 32; item += gridDim.x) {
        const int vs = item & 3, dir = (item >> 2) & 1, h = (item >> 3) & 3, b = item >> 5;
        asm volatile("" : "+v"(tid)); const int ti = tid;
        const int w = ti >> 6, fr = ti & 15, fq = (ti & 63) >> 4;
        const float lg2 = log2f(1.0f - exp2f(-decay[dir * 4 + h]));
        const float gC = exp2f(128.0f * lg2);
        const int ql = w * 16 + fr;
        const float qd = exp2f(lg2 * (float)(dir ? (128 - ql) : (ql + 1)));
        const float rs = exp2f(lg2 * (float)(dir ? (-ql) : (ql - 127)));
        const float kd0 = exp2f(lg2 * (float)(dir ? (ti >> 5) : (127 - (ti >> 5)))), kdstep = exp2f(lg2 * (dir ? 16.0f : -16.0f));
        const int qlo = dir ? (ql + 1) : 0, qhi = dir ? 127 : ql;
        const int lo2 = qlo - 8 * fq, hi2 = qhi - 8 * fq;
        f32x4 st[2][8];
#pragma unroll
        for (int rt = 0; rt < 2; ++rt)
#pragma unroll
            for (int c = 0; c < 8; ++c) st[rt][c] = (f32x4){0.f, 0.f, 0.f, 0.f};
        const int qcol = (dir ? 2048 : 0) + h * 256, kcol = (dir ? 3072 : 1024) + h * 256, vcol = 4096 + h * 512 + vs * 128;
        bf16x8 qfrag[8];
        { const bf16_t* qp0 = proj + (size_t)(b * SEQ + (dir ? 31 : 0) * 128 + ql) * 8192 + qcol;
#pragma unroll
            for (int s = 0; s < 8; ++s) qfrag[s] = *(const bf16x8*)(qp0 + 32 * s + 8 * fq); }
        for (int step = 0; step < 32; ++step) {
            const int cidx = dir ? (31 - step) : step, row0 = b * SEQ + cidx * 128;
            asm volatile("" : "+v"(tid)); const int tz = tid;
            const int zw = tz >> 6, zl = tz & 63, zfr = zl & 15, zfq = zl >> 4;
            const int w = zw, fr = zfr, fq = zfq, ql = zw * 16 + zfr; const unsigned xs = zfr & 3;
            LAS const unsigned char* sb1 = R1 + off_b(zfr, zfq ^ (4 * xs));
            LAS const unsigned char* kb1[2]; LAS const unsigned char* vb2[2]; unsigned xe2[2];
#pragma unroll
            for (int hh = 0; hh < 2; ++hh) kb1[hh] = R1 + off_b(8 * (zfr >> 2) + 4 * hh + (zfr & 3), zfq ^ (4 * xs));
#pragma unroll
            for (int t = 0; t < 2; ++t) { const unsigned q = (unsigned)zfr >> 2, pp = zfr & 3, Xt = (q << 2) | ((2 * zfq + t) & 3);
                vb2[t] = RV + 256 * (8 * zfq + 4 * t + q) + 16 * ((pp >> 1) ^ (Xt & 1)) + 8 * (pp & 1); xe2[t] = Xt >> 1; }
            LAS const unsigned char* ktb[2][2]; LAS unsigned char* swb[2];
#pragma unroll
            for (int rt = 0; rt < 2; ++rt) { swb[rt] = R1 + (zw >> 2) * 32768 + off_b(zfr, 4 * (zw & 3) + 2 * rt + (zfq >> 1)) + 8 * (zfq & 1);
#pragma unroll
                for (int t = 0; t < 2; ++t) ktb[rt][t] = R1 + (zw >> 2) * 32768 + tr_addr16(zl, 2 * (zw & 3) + rt, 0, t); }
            LAS unsigned char* kwb = R1 + ((tz & 31) >> 4) * 32768 + off_b(tz >> 5, tz & 15);
            LAS unsigned char* vwb = RV + off_b(tz >> 4, tz & 15);
            u32x4 kraw[8], vraw[4];
            const bf16_t* kg = proj + (size_t)(row0 + (tz >> 5)) * 8192 + kcol + (tz & 31) * 8;
            const bf16_t* vg = proj + (size_t)(row0 + (tz >> 4)) * 8192 + vcol + (tz & 15) * 8;
#pragma unroll
            for (int i = 0; i < 4; ++i) kraw[i] = *(const u32x4*)(kg + (size_t)i * 16 * 8192);
            f32x4 oacc[8];
#pragma unroll
            for (int c = 0; c < 8; ++c) oacc[c] = (f32x4){0.f, 0.f, 0.f, 0.f};
            if (step > 0) {
                bf16x8 fbuf[2][4];
#define QS_LOAD(G, BUF) { _Pragma("unroll") for (int j = 0; j < 4; ++j) { const int n = 4 * (G) + j, c = n >> 3, s = n & 7; fbuf[BUF][j] = *(const LAS bf16x8*)(sb1 + 64 * ((s & 3) ^ xs) + 4096 * c + 32768 * (s >> 2)); } }
                QS_LOAD(0, 0)
#pragma unroll
                for (int g = 0; g < 16; ++g) {
                    if (g + 1 < 16) QS_LOAD(g + 1, (g + 1) & 1)
                    __builtin_amdgcn_sched_barrier(0);
#pragma unroll
                    for (int j = 0; j < 4; ++j) { const int n = 4 * g + j, c = n >> 3, s = n & 7; oacc[c] = mfma16(fbuf[g & 1][j], qfrag[s], oacc[c]); }
                    __builtin_amdgcn_sched_barrier(0);
                }
#undef QS_LOAD
#pragma unroll
                for (int c = 0; c < 8; ++c) oacc[c] = oacc[c] * qd;
            }
#pragma unroll
            for (int i = 4; i < 8; ++i) kraw[i] = *(const u32x4*)(kg + (size_t)i * 16 * 8192);
            __syncthreads();
#pragma unroll
            for (int i = 0; i < 4; ++i) vraw[i] = *(const u32x4*)(vg + (size_t)i * 32 * 8192);
            { float kd = kd0;
#pragma unroll
              for (int i = 0; i < 8; ++i) {
                float x[8]; unpack8(kraw[i], x);
#pragma unroll
                for (int e = 0; e < 8; ++e) x[e] *= kd;
                *(LAS u32x4*)(kwb + 4096 * i) = pack8(x); kd *= kdstep; } }
#pragma unroll
            for (int i = 0; i < 4; ++i) *(LAS u32x4*)(vwb + 8192 * i) = vraw[i];
            __syncthreads();
            f32x4 sacc[8];
#pragma unroll
            for (int tt = 0; tt < 8; ++tt) sacc[tt] = (f32x4){0.f, 0.f, 0.f, 0.f};
            {
                bf16x8 fbuf[2][4];
#define ST_LOAD(G, BUF) { _Pragma("unroll") for (int j = 0; j < 4; ++j) { const int n = 4 * (G) + j, tt = n >> 3, s = n & 7; fbuf[BUF][j] = *(const LAS bf16x8*)(kb1[tt & 1] + 64 * ((s & 3) ^ xs) + 8192 * (tt >> 1) + 32768 * (s >> 2)); } }
                ST_LOAD(0, 0)
#pragma unroll
                for (int g = 0; g < 16; ++g) {
                    if (g + 1 < 16) ST_LOAD(g + 1, (g + 1) & 1)
                    __builtin_amdgcn_sched_barrier(0);
#pragma unroll
                    for (int j = 0; j < 4; ++j) { const int n = 4 * g + j, tt = n >> 3, s = n & 7; sacc[tt] = mfma16(fbuf[g & 1][j], qfrag[s], sacc[tt]); }
                    __builtin_amdgcn_sched_barrier(0);
                }
#undef ST_LOAD
            }
            bf16x8 pfrag[4];
#pragma unroll
            for (int m = 0; m < 4; ++m) { float pv[8];
#pragma unroll
                for (int i = 0; i < 8; ++i) { const int kc = 32 * m + i; const bool keep = (kc >= lo2) && (kc <= hi2);
                    pv[i] = keep ? sacc[2 * m + (i >> 2)][i & 3] * rs : 0.f; }
                pfrag[m] = __builtin_bit_cast(bf16x8, pack8(pv)); }
#pragma unroll
            for (int rt = 0; rt < 2; ++rt)
#pragma unroll
                for (int c = 0; c < 8; ++c) st[rt][c] = st[rt][c] * gC;
            if (step < 31) { const int ncidx = dir ? (30 - step) : (step + 1); const bf16_t* qpn = proj + (size_t)(b * SEQ + ncidx * 128 + (tz >> 6) * 16 + ((tz & 63) & 15)) * 8192 + qcol + 8 * ((tz & 63) >> 4);
#pragma unroll
                for (int s = 0; s < 8; ++s) qfrag[s] = *(const bf16x8*)(qpn + 32 * s); }
            {
                bf16x8 vfb[2][2], ktq[2][2];
#define TR8(PTR_LO, PTR_HI, DST) { const s16x4 lo_ = __builtin_amdgcn_ds_read_tr16_b64_v4i16((LAS s16x4*)(PTR_LO)), hi_ = __builtin_amdgcn_ds_read_tr16_b64_v4i16((LAS s16x4*)(PTR_HI)); \
        DST[0] = lo_[0]; DST[1] = lo_[1]; DST[2] = lo_[2]; DST[3] = lo_[3]; DST[4] = hi_[0]; DST[5] = hi_[1]; DST[6] = hi_[2]; DST[7] = hi_[3]; }
#define VF_LOAD(G, BUF) { _Pragma("unroll") for (int j = 0; j < 2; ++j) { const int ks = (G) >> 2, c = 2 * ((G) & 3) + j; TR8(vb2[0] + 32 * (c ^ xe2[0]) + 8192 * ks, vb2[1] + 32 * (c ^ xe2[1]) + 8192 * ks, vfb[BUF][j]) } }
#define KT_LOAD(KS, BUF) { _Pragma("unroll") for (int rt = 0; rt < 2; ++rt) TR8(ktb[rt][0] + 8192 * (KS), ktb[rt][1] + 8192 * (KS), ktq[BUF][rt]) }
                KT_LOAD(0, 0) VF_LOAD(0, 0)
#pragma unroll
                for (int g = 0; g < 16; ++g) {
                    if (g + 1 < 16) VF_LOAD(g + 1, (g + 1) & 1)
                    if ((g & 3) == 3 && g + 1 < 16) KT_LOAD((g + 1) >> 2, ((g + 1) >> 2) & 1)
                    __builtin_amdgcn_sched_barrier(0);
#pragma unroll
                    for (int j = 0; j < 2; ++j) { const int ks = g >> 2, c = 2 * (g & 3) + j;
                        oacc[c] = mfma16(vfb[g & 1][j], pfrag[ks], oacc[c]); st[0][c] = mfma16(ktq[ks & 1][0], vfb[g & 1][j], st[0][c]); st[1][c] = mfma16(ktq[ks & 1][1], vfb[g & 1][j], st[1][c]); }
                    __builtin_amdgcn_sched_barrier(0);
                }
#undef VF_LOAD
#undef KT_LOAD
#undef TR8
            }
            { bf16_t* op = outbuf + (size_t)dir * MH * 2048 + (size_t)(row0 + ql) * 2048 + h * 512 + vs * 128;
#pragma unroll
                for (int c = 0; c < 8; ++c) { u32x2 pw; pw.x = cvt_pk_bf16(oacc[c][0], oacc[c][1]); pw.y = cvt_pk_bf16(oacc[c][2], oacc[c][3]); *(u32x2*)(op + 16 * c + 4 * fq) = pw; } }
            __syncthreads();
#pragma unroll
            for (int rt = 0; rt < 2; ++rt)
#pragma unroll
                for (int c = 0; c < 8; ++c) { u32x2 pw; pw.x = cvt_pk_bf16(st[rt][c][0], st[rt][c][1]); pw.y = cvt_pk_bf16(st[rt][c][2], st[rt][c][3]);
                    *(LAS u32x2*)(swb[rt] + 4096 * c) = pw; }
            __syncthreads();
        }
    }
}

__device__ __forceinline__ void ret_combine_phase(const int tid, bf16_t* proj, const bf16_t* outbuf) {
    const int lane = tid & 63, gw = blockIdx.x * 8 + (tid >> 6), nw = gridDim.x * 8;
    if (((MH * 4) % (2 * nw)) != 0) return;
    for (int task0 = gw; task0 < MH * 4; task0 += 2 * nw) {
        u32x4 ra[2], rb[2], rg[2];
#pragma unroll
        for (int t2 = 0; t2 < 2; ++t2) { const int task = task0 + t2 * nw, row = task >> 2, h = task & 3, col = h * 512 + lane * 8;
            ra[t2] = *(const u32x4*)(outbuf + (size_t)row * 2048 + col); rb[t2] = *(const u32x4*)(outbuf + (size_t)MH * 2048 + (size_t)row * 2048 + col);
            rg[t2] = *(const u32x4*)(proj + (size_t)row * 8192 + 6144 + col); }
#pragma unroll
        for (int t2 = 0; t2 < 2; ++t2) { const int task = task0 + t2 * nw, row = task >> 2, h = task & 3, col = h * 512 + lane * 8;
            float a[8], bq[8], gt[8], o[8]; unpack8(ra[t2], a); unpack8(rb[t2], bq); unpack8(rg[t2], gt);
            float ss = 0.f;
#pragma unroll
            for (int e = 0; e < 8; ++e) { a[e] += bq[e]; ss += a[e] * a[e]; }
            ss = wave_sum(ss);
            const float rstd = __builtin_amdgcn_rsqf(ss * (1.0f / 512.0f) + EPS);
#pragma unroll
            for (int e = 0; e < 8; ++e) o[e] = a[e] * rstd * silu_f(gt[e]);
            *(u32x4*)(proj + (size_t)row * 8192 + col) = pack8(o); }
    }
}

__device__ __forceinline__ void grid_barrier(unsigned* ctr, unsigned target) {
    asm volatile("s_waitcnt vmcnt(0) lgkmcnt(0)" ::: "memory");
    __syncthreads();
    if (threadIdx.x < 64) {
        asm volatile("buffer_wbl2 sc1\n\ts_waitcnt vmcnt(0)" ::: "memory");
        if (threadIdx.x == 0) {
            __hip_atomic_fetch_add(ctr, 1u, __ATOMIC_RELAXED, __HIP_MEMORY_SCOPE_AGENT);
            while (__hip_atomic_load(ctr, __ATOMIC_RELAXED, __HIP_MEMORY_SCOPE_AGENT) < target) __builtin_amdgcn_s_sleep(2);
        }
        asm volatile("buffer_inv sc1\n\ts_waitcnt vmcnt(0)" ::: "memory");
    }
    __syncthreads();
}

#define PH_N 28
static __device__ const unsigned char PH_TAB[PH_N] = {1, 2, 4, 9, 10, 12, 17, 18, 19, 20, 25, 26, 27, 28, 33, 34, 35, 36, 41, 42, 43, 44, 49, 50, 52, 57, 58, 60};

__global__ void __launch_bounds__(512, 2) mega_fwd(Params p) {
    extern __shared__ __attribute__((aligned(16))) unsigned char smem[];
    LAS unsigned char* lds = (LAS unsigned char*)smem;
    cg::grid_group grid = cg::this_grid();
    unsigned char* ws = p.ws;
    bf16_t* wt_pool_in = (bf16_t*)(ws + WS_WT_POOL_IN); bf16_t* wt_pool_g = (bf16_t*)(ws + WS_WT_POOL_G); bf16_t* wt_pool_out = (bf16_t*)(ws + WS_WT_POOL_OUT);
    bf16_t* wt_att_in = (bf16_t*)(ws + WS_WT_ATT_IN); bf16_t* wt_att_out = (bf16_t*)(ws + WS_WT_ATT_OUT);
    bf16_t* wt_ret_in = (bf16_t*)(ws + WS_WT_RET_IN); bf16_t* wt_ret_out = (bf16_t*)(ws + WS_WT_RET_OUT);
    float* ret_cos = (float*)(ws + WS_RET_COS); float* ret_sin = (float*)(ws + WS_RET_SIN); float* att_cos = (float*)(ws + WS_ATT_COS); float* att_sin = (float*)(ws + WS_ATT_SIN);
    float* lse = (float*)(ws + WS_LSE); bf16_t* hbuf = (bf16_t*)(ws + WS_H); bf16_t* proj = (bf16_t*)(ws + WS_PROJ);
    bf16_t* pool_diff = (bf16_t*)(ws + WS_PROJ + 256 * MiB); bf16_t* ret_out = (bf16_t*)(ws + WS_PROJ + 512 * MiB);

    unsigned* bar_ctr = (unsigned*)(ws + WS_END); unsigned bar_n = 0;
    grid.sync();
    int tid0 = threadIdx.x; asm volatile("" : "+v"(tid0));
    transpose_batch(tid0, lds, p.pool_w_in + 2048, wt_pool_in + (size_t)2048 * 1024, 1024, 2048, 2, 4096, (size_t)1024 * 4096, (size_t)4096 * 1024);
    convert_rows(tid0, p.pool_w_in, pool_diff, 1024, 2048, 4096); convert_rows(tid0, p.pool_w_in + (size_t)1024 * 4096, pool_diff + (size_t)1024 * 2048, 1024, 2048, 4096);
    transpose_batch(tid0, lds, p.pool_w_group, wt_pool_g, 512, 512, 8);
    transpose_batch(tid0, lds, p.pool_w_out, wt_pool_out, 2048, 1024, 2);
    bar_n += gridDim.x; grid_barrier(bar_ctr, bar_n);
    for (int l = 0; l < 2; ++l) { pg8::EpiStore E; E.O = wt_pool_in + (size_t)l * 4096 * 1024; E.ldc = 1024;
        run_gemm(tid0, lds, wt_pool_g + (size_t)l * 2048 * 512, 512, pool_diff + (size_t)l * 1024 * 2048, 2048, 2048, 1024, 512, 0, E, 2); }
    transpose_batch(tid0, lds, p.att_w_in, wt_att_in, 1024, 10240, 1);
    transpose_batch(tid0, lds, p.att_w_out, wt_att_out, 1024, 1024, 1);
    transpose_batch(tid0, lds, p.ret_w_in, wt_ret_in, 1024, 8192, 1);
    transpose_batch(tid0, lds, p.ret_w_out, wt_ret_out, 2048, 1024, 1);
    rope_tables(tid0, ret_cos, ret_sin, att_cos, att_sin);
    rmsnorm_phase(tid0, p.x, p.pool_norm, hbuf);
    bar_n += gridDim.x; grid_barrier(bar_ctr, bar_n);

    for (int ph = 0; ph < PH_N; ++ph) {
        int tid = threadIdx.x; asm volatile("" : "+v"(tid));
        const int code = PH_TAB[ph], lh = code >> 3, sub = code & 7, layer = lh >> 1, half = lh & 1;
        const int kind = layer % 3, idx = layer / 3;
        const size_t xo = (size_t)half * MH * DM;
        if (sub == 0) {
            int lo = layer; asm volatile("" : "+s"(lo));
            const float* xsrc = (lo == 0 ? p.x : p.out) + xo;
            rmsnorm_phase(tid, xsrc, kind == 0 ? p.pool_norm + idx * 1024 : (kind == 1 ? p.att_norm : p.ret_norm), hbuf);
        } else if (sub == 4) {
            const bf16_t* A = kind == 0 ? pool_diff : proj; const int lda = kind == 0 ? 2048 : (kind == 1 ? 10240 : 8192), K = kind == 1 ? 1024 : 2048;
            const bf16_t* Bt = kind == 0 ? wt_pool_out + (size_t)idx * 1024 * 2048 : (kind == 1 ? wt_att_out : wt_ret_out);
            int lo = layer; asm volatile("" : "+s"(lo));
            const float* xsrc = (lo == 0 ? p.x : p.out) + xo; float* xdst = p.out + xo;
            pg8::EpiResid E; E.base = xsrc; E.out = xdst; run_gemm(tid, lds, A, lda, Bt, K, MH, 1024, K, 0, E);
            if (lh + 1 < 8) { int l2 = (lh + 1) >> 1; const int h2 = (lh + 1) & 1, k2 = l2 % 3, i2 = l2 / 3; asm volatile("" : "+s"(l2));
                const float* xs2 = (l2 == 0 ? p.x : p.out) + (size_t)h2 * MH * DM;
                rmsnorm_phase(tid, xs2, k2 == 0 ? p.pool_norm + i2 * 1024 : (k2 == 1 ? p.att_norm : p.ret_norm), hbuf); }
        } else if (sub == 1) {
            if (kind == 2) { pg8::EpiRet E; E.O = proj; E.cosT = ret_cos; E.sinT = ret_sin; run_gemm(tid, lds, hbuf, 1024, wt_ret_in, 1024, MH, 8192, 1024, 0, E); }
            else { const int N = kind == 0 ? 4096 : 10240; const bf16_t* Bt = kind == 0 ? wt_pool_in + (size_t)idx * 4096 * 1024 : wt_att_in;
                pg8::EpiStore E; E.O = proj; E.ldc = N; run_gemm(tid, lds, hbuf, 1024, Bt, 1024, MH, N, 1024, 0, E); }
        } else if (sub == 2) {
            if (kind == 0) pool_mix_phase(tid, proj, p.pool_scale + idx * 2048, pool_diff);
            else if (kind == 1) attn_phase(tid, lds, proj, lse, p.att_q_norm, p.att_k_norm, att_cos, att_sin);
            else ret_chain_phase(tid, lds, proj, ret_out, p.ret_decay);
        } else if (sub == 3) {
            if (kind == 0) { }
            else if (kind == 1) attn_combine_phase(tid, proj, lse);
            else ret_combine_phase(tid, proj, ret_out);
        }
        bar_n += gridDim.x; grid_barrier(bar_ctr, bar_n);
    }
}

extern "C" void kernel_launch(void* const* d_in, const int* in_sizes, int n_in, void* d_out, int out_size, void* d_ws, size_t ws_size, hipStream_t stream) {
    constexpr int LDS_BYTES = 135168;
    static int grid_blocks = 0;
    if (grid_blocks == 0) {
        if (n_in != 15 || ws_size < WS_END + 256) { fprintf(stderr, "kernel_launch: unexpected n_in %d / ws_size %zu (need %zu)\n", n_in, ws_size, (size_t)WS_END); grid_blocks = -1; return; }
        int dev = 0, cus = 0, per_cu = 0;
        hipGetDevice(&dev);
        hipDeviceGetAttribute(&cus, hipDeviceAttributeMultiprocessorCount, dev);
        if (hipFuncSetAttribute((const void*)mega_fwd, hipFuncAttributeMaxDynamicSharedMemorySize, LDS_BYTES) != hipSuccess) { fprintf(stderr, "kernel_launch: hipFuncSetAttribute failed\n"); }
        hipOccupancyMaxActiveBlocksPerMultiprocessor(&per_cu, (const void*)mega_fwd, 512, LDS_BYTES);
        (void)hipGetLastError();
        if (per_cu < 1) per_cu = 1;
        grid_blocks = cus;
    }
    if (grid_blocks < 0) return;
    (void)hipMemsetAsync((unsigned char*)d_ws + WS_END, 0, 256, stream);
    Params p{};
    p.x = (const float*)d_in[0]; p.pool_norm = (const float*)d_in[1]; p.pool_w_in = (const float*)d_in[2]; p.pool_w_group = (const float*)d_in[3];
    p.pool_scale = (const float*)d_in[4]; p.pool_w_out = (const float*)d_in[5]; p.att_norm = (const float*)d_in[6]; p.att_w_in = (const float*)d_in[7];
    p.att_q_norm = (const float*)d_in[8]; p.att_k_norm = (const float*)d_in[9]; p.att_w_out = (const float*)d_in[10]; p.ret_norm = (const float*)d_in[11];
    p.ret_w_in = (const float*)d_in[12]; p.ret_decay = (const float*)d_in[13]; p.ret_w_out = (const float*)d_in[14];
    p.out = (float*)d_out; p.ws = (unsigned char*)d_ws;
    void* args[] = {&p};
    hipError_t e = hipLaunchCooperativeKernel((const void*)mega_fwd, dim3(grid_blocks), dim3(512), args, LDS_BYTES, stream);
    if (e != hipSuccess) fprintf(stderr, "cooperative launch failed: %s (grid %d)\n", hipGetErrorString(e), grid_blocks);
}
```

```cpp
#include <hip/hip_runtime.h>
#include <hip/hip_cooperative_groups.h>
#include <cstdio>
namespace cg = cooperative_groups;

#define LAS __attribute__((address_space(3)))
typedef unsigned short bf16_t;
typedef short bf16x8 __attribute__((ext_vector_type(8)));
typedef short s16x4 __attribute__((ext_vector_type(4)));
typedef float f32x4 __attribute__((ext_vector_type(4)));
typedef unsigned u32x4 __attribute__((ext_vector_type(4)));
typedef unsigned u32x2 __attribute__((ext_vector_type(2)));

constexpr int SEQ = 4096, DM = 1024, NB = 16;
constexpr int HB = 8;
constexpr int MH = HB * SEQ;
constexpr float EPS = 1e-6f;
constexpr size_t MiB = 1024ull * 1024ull;
constexpr size_t WS_WT_POOL_IN  = 0;
constexpr size_t WS_WT_POOL_G   = 16 * MiB;
constexpr size_t WS_WT_POOL_OUT = 20 * MiB;
constexpr size_t WS_WT_ATT_IN   = 28 * MiB;
constexpr size_t WS_WT_ATT_OUT  = 48 * MiB;
constexpr size_t WS_WT_RET_IN   = 50 * MiB;
constexpr size_t WS_WT_RET_OUT  = 66 * MiB;
constexpr size_t WS_RET_COS     = 70 * MiB;
constexpr size_t WS_RET_SIN     = 72 * MiB;
constexpr size_t WS_ATT_COS     = 74 * MiB;
constexpr size_t WS_ATT_SIN     = 74 * MiB + 512 * 1024;
constexpr size_t WS_LSE         = 75 * MiB;
constexpr size_t WS_H           = 78 * MiB;
constexpr size_t WS_PROJ        = 142 * MiB;
constexpr size_t WS_END         = 142 * MiB + 768 * MiB;

struct Params {
    const float* x; const float* pool_norm; const float* pool_w_in; const float* pool_w_group; const float* pool_scale; const float* pool_w_out;
    const float* att_norm; const float* att_w_in; const float* att_q_norm; const float* att_k_norm; const float* att_w_out;
    const float* ret_norm; const float* ret_w_in; const float* ret_decay; const float* ret_w_out;
    float* out; unsigned char* ws;
};

typedef float f32x2 __attribute__((ext_vector_type(2)));
typedef __bf16 bf16x2_t __attribute__((ext_vector_type(2)));
__device__ __forceinline__ unsigned cvt_pk_bf16(float lo, float hi) { f32x2 v = {lo, hi}; return __builtin_bit_cast(unsigned, __builtin_convertvector(v, bf16x2_t)); }
__device__ __forceinline__ float bf_lo(unsigned w) { return __uint_as_float(w << 16); }
__device__ __forceinline__ float bf_hi(unsigned w) { return __uint_as_float(w & 0xffff0000u); }
__device__ __forceinline__ f32x4 mfma16(bf16x8 a, bf16x8 b, f32x4 c) { return __builtin_amdgcn_mfma_f32_16x16x32_bf16(a, b, c, 0, 0, 0); }
__device__ __forceinline__ float silu_f(float g) { return g * __builtin_amdgcn_rcpf(1.0f + __expf(-g)); }
__device__ __forceinline__ unsigned off_b(unsigned row, unsigned ch) { return 256u * row + 16u * (ch ^ (((row & 3u) << 2) | ((row >> 2) & 3u))); }
__device__ __forceinline__ unsigned tr_addr16(unsigned lane, unsigned c, unsigned ks, unsigned t) {
    const unsigned g = lane >> 4, q = (lane & 15u) >> 2, p = lane & 3u;
    return off_b(32u * ks + 8u * g + 4u * t + q, 2u * c + (p >> 1)) + 8u * (p & 1u);
}
__device__ __forceinline__ bf16x8 tr_read2(unsigned a0, unsigned a1) {
    const s16x4 lo = __builtin_amdgcn_ds_read_tr16_b64_v4i16((LAS s16x4*)a0), hi = __builtin_amdgcn_ds_read_tr16_b64_v4i16((LAS s16x4*)a1);
    bf16x8 r; r[0] = lo[0]; r[1] = lo[1]; r[2] = lo[2]; r[3] = lo[3]; r[4] = hi[0]; r[5] = hi[1]; r[6] = hi[2]; r[7] = hi[3]; return r;
}
template <int CTRL> __device__ __forceinline__ float dpp_f(float x) { return __int_as_float(__builtin_amdgcn_update_dpp(__float_as_int(x), __float_as_int(x), CTRL, 0xF, 0xF, false)); }
__device__ __forceinline__ float row16_sum(float s) { s += dpp_f<0xB1>(s); s += dpp_f<0x4E>(s); s += dpp_f<0x124>(s); s += dpp_f<0x128>(s); return s; }
__device__ __forceinline__ float xrow16_sum(float x) {
    auto s_ = __builtin_amdgcn_permlane16_swap(__float_as_uint(x), __float_as_uint(x), false, false); x = __uint_as_float(s_[0]) + __uint_as_float(s_[1]);
    auto t_ = __builtin_amdgcn_permlane32_swap(__float_as_uint(x), __float_as_uint(x), false, false); return __uint_as_float(t_[0]) + __uint_as_float(t_[1]); }
__device__ __forceinline__ float xrow16_max(float x) {
    auto s_ = __builtin_amdgcn_permlane16_swap(__float_as_uint(x), __float_as_uint(x), false, false); x = fmaxf(__uint_as_float(s_[0]), __uint_as_float(s_[1]));
    auto t_ = __builtin_amdgcn_permlane32_swap(__float_as_uint(x), __float_as_uint(x), false, false); return fmaxf(__uint_as_float(t_[0]), __uint_as_float(t_[1])); }
__device__ __forceinline__ float wave_sum(float x) { return xrow16_sum(row16_sum(x)); }
__device__ __forceinline__ float lane_xor32(float x, bool lower_half) {
    auto t_ = __builtin_amdgcn_permlane32_swap(__float_as_uint(x), __float_as_uint(x), false, false); return lower_half ? __uint_as_float(t_[1]) : __uint_as_float(t_[0]); }
__device__ __forceinline__ u32x4 pack8(const float (&v)[8]) { u32x4 w; w.x = cvt_pk_bf16(v[0], v[1]); w.y = cvt_pk_bf16(v[2], v[3]); w.z = cvt_pk_bf16(v[4], v[5]); w.w = cvt_pk_bf16(v[6], v[7]); return w; }
__device__ __forceinline__ void unpack8(u32x4 w, float (&v)[8]) { v[0] = bf_lo(w.x); v[1] = bf_hi(w.x); v[2] = bf_lo(w.y); v[3] = bf_hi(w.y); v[4] = bf_lo(w.z); v[5] = bf_hi(w.z); v[6] = bf_lo(w.w); v[7] = bf_hi(w.w); }

namespace pg8 {
#define PG8_LAS __attribute__((address_space(3)))
constexpr int BM = 256, BK = 64, HALF = 128, HTB = HALF * BK * 2, STAGE_BYTES = 8 * HTB, NXCD = 8, WGM = 8;
__device__ __forceinline__ int lds_byte(int r, int c) { const int st = (r >> 4) * 2 + (c >> 5), rr = r & 15, cc = c & 31, ob = rr * 64 + cc * 2; return st * 1024 + (ob ^ (((ob >> 9) & 1) << 5)); }
__device__ __forceinline__ void stage_rc(int b, int& R, int& C) { const int st = b / 1024, sb = b % 1024, swz = sb ^ (((sb >> 9) & 1) << 5); R = (st >> 1) * 16 + swz / 64; C = (st & 1) * 32 + (swz % 64) / 2; }
__device__ __forceinline__ int perm32(int rho) { const int n = rho >> 4, i = rho & 15; return 8 * (i >> 2) + 4 * n + (i & 3); }
struct Unit { int pm, pn; };
struct Gemm { const bf16_t* A; const bf16_t* Bt; int M, N, K, lda, ldb, agrp, bgrp; };
struct StaticOrder {
    int nM, nN, nwg, G, c;
    __device__ void init(int M, int N, int G_, int c_) { nM = M / BM; nN = N / BM; nwg = nM * nN; G = G_; c = c_; }
    __device__ bool next(int i, Unit& u) const {
        const long L = (long)i * G + c; if (L >= nwg) return false;
        int wgid = (int)L; { const int q = nwg / NXCD, r = nwg % NXCD, xcd = wgid % NXCD, off = wgid / NXCD; wgid = (xcd < r ? xcd * (q + 1) : r * (q + 1) + (xcd - r) * q) + off; }
        const int nig = WGM * nN, gid = wgid / nig, fm = gid * WGM, gsz = (nM - fm) < WGM ? (nM - fm) : WGM;
        u.pm = fm + ((wgid % nig) % gsz); u.pn = (wgid % nig) / gsz; return true;
    }
};

template <class Epi>
__device__ __forceinline__ void gemm_phase(const int tid, PG8_LAS unsigned char* lds, const Gemm g, const StaticOrder& S, const Epi& E) {
    const int wid = __builtin_amdgcn_readfirstlane(tid >> 6), lane = tid & 63, wr = wid >> 2, wc = wid & 3, fr = lane & 15, fq = lane >> 4;
    const int K = g.K, nt = K / BK;
    unsigned voffA[2], voffB[2];
#pragma unroll
    for (int i = 0; i < 2; ++i) { int R, C; stage_rc(tid * 16 + i * 8192, R, C); const int Rb = Epi::PERM ? ((R & ~31) + perm32(R & 31)) : R;
        voffA[i] = (unsigned)(R * g.lda + C) * 2u; voffB[i] = (unsigned)(Rb * g.ldb + C) * 2u; }
    const size_t kstep = (size_t)(BK * 2);
    const size_t hstepA = (size_t)HALF * g.lda * 2, hstepB = (size_t)HALF * g.ldb * 2;
    const size_t tstepA = 2 * hstepA, tstepB = 2 * hstepB;
    const unsigned ldsw = (unsigned)wid * 1024u;
    const int aoff = lds_byte(wr * 64 + fr, fq * 8), boff = lds_byte(wc * 32 + fr, fq * 8);
#define PG8_SA(b, h) (((b) * 2 + (h)) * HTB)
#define PG8_SB(b, h) ((4 + (b) * 2 + (h)) * HTB)
#define PG8_STAGE(bufoff, gbase, voff) do { _Pragma("unroll") for (int _i = 0; _i < 2; ++_i) \
        __builtin_amdgcn_global_load_lds((const unsigned*)((const char*)(gbase) + (voff)[_i]), (PG8_LAS unsigned*)(lds + (bufoff) + ldsw + _i * 8192), 16, 0, 0); } while (0)
#define PG8_LDA(dst, b, h) do { _Pragma("unroll") for (int m = 0; m < 4; ++m) _Pragma("unroll") for (int k = 0; k < 2; ++k) dst[m][k] = *(const PG8_LAS bf16x8*)(lds + PG8_SA(b, h) + aoff + m * 2048 + k * 1024); } while (0)
#define PG8_LDB(dst, b, h) do { _Pragma("unroll") for (int n = 0; n < 2; ++n) _Pragma("unroll") for (int k = 0; k < 2; ++k) dst[n][k] = *(const PG8_LAS bf16x8*)(lds + PG8_SB(b, h) + boff + n * 2048 + k * 1024); } while (0)
#define PG8_MMA(ai, bj, At, Bt) do { __builtin_amdgcn_s_setprio(1); _Pragma("unroll") for (int m = 0; m < 4; ++m) _Pragma("unroll") for (int n = 0; n < 2; ++n) _Pragma("unroll") for (int k = 0; k < 2; ++k) \
        acc[ai][bj][m][n] = __builtin_amdgcn_mfma_f32_16x16x32_bf16(Bt[n][k], At[m][k], acc[ai][bj][m][n], 0, 0, 0); __builtin_amdgcn_s_setprio(0); } while (0)
#define PG8_WAIT_V(n) asm volatile("s_waitcnt vmcnt(" #n ")" ::: "memory")
#define PG8_WAIT_L(n) asm volatile("s_waitcnt lgkmcnt(" #n ")" ::: "memory")
#define PG8_BAR __builtin_amdgcn_s_barrier()
#define PG8_SCHED __builtin_amdgcn_sched_barrier(0)
#define PG8_ABASE(u) ((const char*)g.A + (size_t)(u).pm * tstepA + (g.agrp ? (size_t)((u).pn / g.agrp) * (size_t)K * 2 : (size_t)0))
#define PG8_BBASE(u) ((const char*)g.Bt + (size_t)(u).pn * tstepB + (g.bgrp ? (size_t)((u).pm / g.bgrp) * (size_t)K * 2 : (size_t)0))
    Unit cur, nxt; int ui = 0;
    if (!S.next(0, cur)) return;
    f32x4 acc[2][2][4][2];
#pragma unroll
    for (int a = 0; a < 2; ++a)
#pragma unroll
        for (int b = 0; b < 2; ++b)
#pragma unroll
            for (int m = 0; m < 4; ++m)
#pragma unroll
                for (int n = 0; n < 2; ++n) acc[a][b][m][n] = (f32x4){0.f, 0.f, 0.f, 0.f};
    bf16x8 At[4][2], B0[2][2], B1[2][2];
    const char* cA = PG8_ABASE(cur); const char* cB = PG8_BBASE(cur);
    PG8_STAGE(PG8_SB(0, 0), cB, voffB); PG8_STAGE(PG8_SA(0, 0), cA, voffA); PG8_STAGE(PG8_SB(0, 1), cB + hstepB, voffB); PG8_STAGE(PG8_SA(0, 1), cA + hstepA, voffA);
    if (wr == 1) PG8_BAR;
    PG8_WAIT_V(4); PG8_BAR;
    PG8_STAGE(PG8_SB(1, 0), cB + kstep, voffB); PG8_STAGE(PG8_SA(1, 0), cA + kstep, voffA); PG8_STAGE(PG8_SB(1, 1), cB + hstepB + kstep, voffB);
    PG8_WAIT_V(6); PG8_BAR;
    for (;;) {
        const bool has_next = S.next(ui + 1, nxt);
        const char* nA = has_next ? PG8_ABASE(nxt) : cA; const char* nB = has_next ? PG8_BBASE(nxt) : cB;
        for (int t = 0; t < nt; t += 2) {
            const bool last = (t == nt - 2);
            const char* a1 = cA + (size_t)(t + 1) * kstep;
            const char* a2 = last ? nA : cA + (size_t)(t + 2) * kstep; const char* b2 = last ? nB : cB + (size_t)(t + 2) * kstep;
            const char* a3 = a2 + kstep; const char* b3 = b2 + kstep;
            PG8_LDB(B0, 0, 0); PG8_SCHED; PG8_LDA(At, 0, 0); PG8_STAGE(PG8_SA(1, 1), a1 + hstepA, voffA);
            PG8_WAIT_L(8); PG8_BAR; PG8_WAIT_L(0); PG8_MMA(0, 0, At, B0); PG8_BAR; PG8_SCHED;
            PG8_LDB(B1, 0, 1); PG8_STAGE(PG8_SB(0, 0), b2, voffB);
            PG8_BAR; PG8_WAIT_L(0); PG8_MMA(0, 1, At, B1); PG8_BAR;
            PG8_LDA(At, 0, 1); PG8_STAGE(PG8_SA(0, 0), a2, voffA);
            PG8_BAR; PG8_WAIT_L(0); PG8_MMA(1, 0, At, B0); PG8_BAR; PG8_SCHED;
            PG8_STAGE(PG8_SB(0, 1), b2 + hstepB, voffB);
            PG8_WAIT_V(6); PG8_BAR; PG8_MMA(1, 1, At, B1); PG8_BAR;
            PG8_LDB(B0, 1, 0); PG8_SCHED; PG8_LDA(At, 1, 0); PG8_STAGE(PG8_SA(0, 1), a2 + hstepA, voffA);
            PG8_WAIT_L(8); PG8_BAR; PG8_WAIT_L(0); PG8_MMA(0, 0, At, B0); PG8_BAR; PG8_SCHED;
            PG8_LDB(B1, 1, 1); PG8_STAGE(PG8_SB(1, 0), b3, voffB);
            PG8_BAR; PG8_WAIT_L(0); PG8_MMA(0, 1, At, B1); PG8_BAR;
            PG8_LDA(At, 1, 1); PG8_STAGE(PG8_SA(1, 0), a3, voffA);
            PG8_BAR; PG8_WAIT_L(0); PG8_MMA(1, 0, At, B0); PG8_BAR; PG8_SCHED;
            PG8_STAGE(PG8_SB(1, 1), b3 + hstepB, voffB);
            PG8_WAIT_V(6); PG8_BAR; PG8_MMA(1, 1, At, B1); PG8_BAR;
        }
        E(acc, cur, wr, wc, fr, fq);
        if (!has_next) break;
#pragma unroll
        for (int a = 0; a < 2; ++a)
#pragma unroll
            for (int b = 0; b < 2; ++b)
#pragma unroll
                for (int m = 0; m < 4; ++m)
#pragma unroll
                    for (int n = 0; n < 2; ++n) acc[a][b][m][n] = (f32x4){0.f, 0.f, 0.f, 0.f};
        cur = nxt; cA = nA; cB = nB; ++ui;
    }
    PG8_WAIT_V(0);
    if (wr == 0) PG8_BAR;
    PG8_BAR;
#undef PG8_SA
#undef PG8_SB
#undef PG8_STAGE
#undef PG8_LDA
#undef PG8_LDB
#undef PG8_MMA
#undef PG8_WAIT_V
#undef PG8_WAIT_L
#undef PG8_BAR
#undef PG8_SCHED
#undef PG8_ABASE
#undef PG8_BBASE
}

struct EpiStore {
    static constexpr bool PERM = true;
    bf16_t* O; int ldc;
    __device__ __forceinline__ void operator()(const f32x4 (&acc)[2][2][4][2], const Unit& u, int wr, int wc, int fr, int fq) const {
        const int row0 = u.pm * BM + wr * 64 + fr, col0 = u.pn * BM + wc * 32 + 8 * fq;
#pragma unroll
        for (int ai = 0; ai < 2; ++ai)
#pragma unroll
            for (int m = 0; m < 4; ++m) { bf16_t* rowp = O + (size_t)(row0 + ai * HALF + m * 16) * ldc + col0;
#pragma unroll
                for (int bj = 0; bj < 2; ++bj) { const f32x4 v0 = acc[ai][bj][m][0], v1 = acc[ai][bj][m][1];
                    u32x4 w; w.x = cvt_pk_bf16(v0[0], v0[1]); w.y = cvt_pk_bf16(v0[2], v0[3]); w.z = cvt_pk_bf16(v1[0], v1[1]); w.w = cvt_pk_bf16(v1[2], v1[3]);
                    *(u32x4*)(rowp + bj * HALF) = w; } }
    }
};
struct EpiResid {
    static constexpr bool PERM = false;
    const float* base; float* out;
    __device__ __forceinline__ void operator()(const f32x4 (&acc)[2][2][4][2], const Unit& u, int wr, int wc, int fr, int fq) const {
        const int row0 = u.pm * BM + wr * 64 + fr, col0 = u.pn * BM + wc * 32 + 4 * fq;
        f32x4 bs[2][2][2][2];
#define ER_LOAD(Q, BUF) { _Pragma("unroll") for (int mm = 0; mm < 2; ++mm) { const size_t off = (size_t)(row0 + ((Q) >> 1) * HALF + (2 * ((Q) & 1) + mm) * 16) * 1024 + col0; \
            _Pragma("unroll") for (int bj = 0; bj < 2; ++bj) _Pragma("unroll") for (int n = 0; n < 2; ++n) bs[BUF][mm][bj][n] = *(const f32x4*)(base + off + bj * HALF + n * 16); } }
#define ER_STORE(Q, BUF) { _Pragma("unroll") for (int mm = 0; mm < 2; ++mm) { const size_t off = (size_t)(row0 + ((Q) >> 1) * HALF + (2 * ((Q) & 1) + mm) * 16) * 1024 + col0; \
            _Pragma("unroll") for (int bj = 0; bj < 2; ++bj) _Pragma("unroll") for (int n = 0; n < 2; ++n) *(f32x4*)(out + off + bj * HALF + n * 16) = bs[BUF][mm][bj][n] + acc[(Q) >> 1][bj][2 * ((Q) & 1) + mm][n]; } }
        ER_LOAD(0, 0) ER_LOAD(1, 1) ER_STORE(0, 0) ER_LOAD(2, 0) ER_STORE(1, 1) ER_LOAD(3, 1) ER_STORE(2, 0) ER_STORE(3, 1)
#undef ER_LOAD
#undef ER_STORE
    }
};
struct EpiRet {
    static constexpr bool PERM = true;
    bf16_t* O; const float* cosT; const float* sinT;
    __device__ __forceinline__ void operator()(const f32x4 (&acc)[2][2][4][2], const Unit& u, int wr, int wc, int fr, int fq) const {
        const int row0 = u.pm * BM + wr * 64 + fr, col0 = u.pn * BM + wc * 32 + 8 * fq;
        const bool rot = u.pn < 16; const float ksc = ((u.pn >> 2) & 1) ? 0.0625f : 1.0f;
        const int tcol = wc * 32 + 8 * fq;
        f32x4 cb[2][2], sb[2][2], cd[2], sd[2];
        if (rot) {
#pragma unroll
            for (int hh = 0; hh < 2; ++hh) { cd[hh] = *(const f32x4*)(cosT + 16 * 128 + tcol + 4 * hh); sd[hh] = *(const f32x4*)(sinT + 16 * 128 + tcol + 4 * hh);
#pragma unroll
                for (int ai = 0; ai < 2; ++ai) { const int ti = ((row0 + ai * HALF) & 4095) * 128 + tcol + 4 * hh; cb[ai][hh] = *(const f32x4*)(cosT + ti); sb[ai][hh] = *(const f32x4*)(sinT + ti); } }
        }
#pragma unroll
        for (int ai = 0; ai < 2; ++ai) {
            f32x4 c0 = cb[ai][0], c1 = cb[ai][1], s0 = sb[ai][0], s1 = sb[ai][1];
#pragma unroll
            for (int m = 0; m < 4; ++m) { const int row = row0 + ai * HALF + m * 16; bf16_t* rowp = O + (size_t)row * 8192 + col0;
                f32x4 a0 = acc[ai][0][m][0], a1 = acc[ai][0][m][1], b0 = acc[ai][1][m][0], b1 = acc[ai][1][m][1];
                if (rot) {
                    const f32x4 o0 = (a0 * c0 - b0 * s0) * ksc, o1 = (a1 * c1 - b1 * s1) * ksc, p0 = (b0 * c0 + a0 * s0) * ksc, p1 = (b1 * c1 + a1 * s1) * ksc;
                    a0 = o0; a1 = o1; b0 = p0; b1 = p1;
                    const f32x4 nc0 = c0 * cd[0] - s0 * sd[0], ns0 = s0 * cd[0] + c0 * sd[0], nc1 = c1 * cd[1] - s1 * sd[1], ns1 = s1 * cd[1] + c1 * sd[1];
                    c0 = nc0; s0 = ns0; c1 = nc1; s1 = ns1; }
                u32x4 w; w.x = cvt_pk_bf16(a0[0], a0[1]); w.y = cvt_pk_bf16(a0[2], a0[3]); w.z = cvt_pk_bf16(a1[0], a1[1]); w.w = cvt_pk_bf16(a1[2], a1[3]);
                *(u32x4*)(rowp) = w;
                w.x = cvt_pk_bf16(b0[0], b0[1]); w.y = cvt_pk_bf16(b0[2], b0[3]); w.z = cvt_pk_bf16(b1[0], b1[1]); w.w = cvt_pk_bf16(b1[2], b1[3]);
                *(u32x4*)(rowp + HALF) = w; }
        }
    }
};
}

template <class Epi>
__device__ __forceinline__ void run_gemm(const int tid, LAS unsigned char* lds, const bf16_t* A, int lda, const bf16_t* Bt, int ldb, int M, int N, int K, int agrp, const Epi& E, int bgrp = 0) {
    pg8::Gemm g; g.A = A; g.Bt = Bt; g.M = M; g.N = N; g.K = K; g.lda = lda; g.ldb = ldb; g.agrp = agrp; g.bgrp = bgrp;
    pg8::StaticOrder S; S.init(M, N, (int)gridDim.x, (int)blockIdx.x);
    pg8::gemm_phase<Epi>(tid, lds, g, S, E);
}

__device__ __forceinline__ void transpose_batch(const int tid, LAS unsigned char* lds, const float* src, bf16_t* dst, int K, int N, int batch, int src_ld = 0, size_t src_bs = 0, size_t dst_bs = 0) {
    LAS float* tile = (LAS float*)lds;
    if (src_ld == 0) src_ld = N; if (src_bs == 0) src_bs = (size_t)K * N; if (dst_bs == 0) dst_bs = (size_t)K * N;
    const int ntk = K / 64, ntn = N / 64, per = ntk * ntn, total = batch * per;
    for (int t = blockIdx.x; t < total; t += gridDim.x) {
        const int bt = t / per, rem = t - bt * per, tk = rem / ntn, tn = rem - tk * ntn;
        const float* s = src + (size_t)bt * src_bs + (size_t)(tk * 64) * src_ld + tn * 64;
        bf16_t* d = dst + (size_t)bt * dst_bs + (size_t)(tn * 64) * K + tk * 64;
#pragma unroll
        for (int i = 0; i < 8; ++i) { const int k = (tid >> 6) + 8 * i, n = tid & 63; tile[k * 65 + n] = s[(size_t)k * src_ld + n]; }
        __syncthreads();
#pragma unroll
        for (int i = 0; i < 8; ++i) { const int n = (tid >> 6) + 8 * i, k = tid & 63; const float v = tile[k * 65 + n]; d[(size_t)n * K + k] = (bf16_t)(cvt_pk_bf16(v, v) & 0xffffu); }
        __syncthreads();
    }
}
__device__ __forceinline__ void convert_rows(const int tid, const float* src, bf16_t* dst, int rows, int ncols, int src_ld) {
    const int per_row = ncols / 4, total = rows * per_row;
    for (int e = blockIdx.x * 512 + tid; e < total; e += gridDim.x * 512) { const int r = e / per_row, c4 = e - r * per_row;
        const f32x4 v = *(const f32x4*)(src + (size_t)r * src_ld + c4 * 4); u32x2 w; w.x = cvt_pk_bf16(v[0], v[1]); w.y = cvt_pk_bf16(v[2], v[3]); *(u32x2*)(dst + (size_t)r * ncols + c4 * 4) = w; }
}
__device__ __forceinline__ void sincos_d(double x, float& s, float& c) {
    const double q = rint(x * 0.63661977236758134308);
    const double r = (x - q * 1.57079632679489655800) - q * 6.12323399573676603587e-17;
    const double r2 = r * r;
    double sp = 1.0 / 6227020800.0; sp = sp * r2 - 1.0 / 39916800.0; sp = sp * r2 + 1.0 / 362880.0; sp = sp * r2 - 1.0 / 5040.0; sp = sp * r2 + 1.0 / 120.0; sp = sp * r2 - 1.0 / 6.0; sp = sp * r2 + 1.0; sp = sp * r;
    double cp = -1.0 / 87178291200.0; cp = cp * r2 + 1.0 / 479001600.0; cp = cp * r2 - 1.0 / 3628800.0; cp = cp * r2 + 1.0 / 40320.0; cp = cp * r2 - 1.0 / 720.0; cp = cp * r2 + 1.0 / 24.0; cp = cp * r2 - 0.5; cp = cp * r2 + 1.0;
    const int qi = ((int)q) & 3;
    const double ss = (qi == 0) ? sp : (qi == 1) ? cp : (qi == 2) ? -sp : -cp;
    const double cc = (qi == 0) ? cp : (qi == 1) ? -sp : (qi == 2) ? -cp : sp;
    s = (float)ss; c = (float)cc;
}
__device__ __forceinline__ void rope_tables(const int tid, float* rc, float* rs, float* ac, float* as) {
    const int gt = blockIdx.x * 512 + tid, gs = gridDim.x * 512;
    for (int e = gt; e < 4096 * 128; e += gs) { const int pos = e >> 7, i = e & 127;
        const float inv = (float)exp2(-13.287712379549449 * ((double)i / 128.0));
        const float ang = (float)pos * inv; float s, c; sincos_d((double)ang, s, c); rc[e] = c; rs[e] = s; }
    for (int e = gt; e < 4096 * 16; e += gs) { const int pos = e >> 4, i = e & 15;
        const float inv = (float)exp2(-18.931568569324174 * ((double)i / 16.0));
        const float ang = (float)pos * inv; float s, c; sincos_d((double)ang, s, c); ac[e] = c; as[e] = s; }
}

__device__ __forceinline__ void rmsnorm_phase(const int tid, const float* x, const float* w, bf16_t* h) {
    const int lane = tid & 63, gw = blockIdx.x * 8 + (tid >> 6), nw = gridDim.x * 8;
    f32x4 wv[4];
#pragma unroll
    for (int i = 0; i < 4; ++i) wv[i] = ((const f32x4*)w)[lane + 64 * i];
    if ((MH % (2 * nw)) != 0) return;
    for (int row = gw; row < MH; row += 2 * nw) {
        f32x4 v[2][4]; float ss[2];
#pragma unroll
        for (int r2 = 0; r2 < 2; ++r2) { const f32x4* xp = (const f32x4*)(x + (size_t)(row + r2 * nw) * 1024);
#pragma unroll
            for (int i = 0; i < 4; ++i) v[r2][i] = xp[lane + 64 * i]; }
#pragma unroll
        for (int r2 = 0; r2 < 2; ++r2) { float a = 0.f;
#pragma unroll
            for (int i = 0; i < 4; ++i) a += v[r2][i][0] * v[r2][i][0] + v[r2][i][1] * v[r2][i][1] + v[r2][i][2] * v[r2][i][2] + v[r2][i][3] * v[r2][i][3];
            ss[r2] = wave_sum(a); }
#pragma unroll
        for (int r2 = 0; r2 < 2; ++r2) { const float rstd = __builtin_amdgcn_rsqf(ss[r2] * (1.0f / 1024.0f) + EPS);
#pragma unroll
            for (int i = 0; i < 4; ++i) { const f32x4 o = v[r2][i] * rstd * wv[i]; u32x2 pk; pk.x = cvt_pk_bf16(o[0], o[1]); pk.y = cvt_pk_bf16(o[2], o[3]);
                *(u32x2*)(h + (size_t)(row + r2 * nw) * 1024 + 4 * (lane + 64 * i)) = pk; } }
    }
}

template <int H>
__device__ __forceinline__ void pool_mix_run(const bf16_t* ub, bf16_t* db, const float (&sc)[8], const int s0) {
    u32x4 ring[2 * H]; float sum[8];
#pragma unroll
    for (int e = 0; e < 8; ++e) sum[e] = 0.f;
#pragma unroll
    for (int k = 0; k < 2 * H; ++k) { const int rr = s0 - H + k; ring[k] = (u32x4){0u, 0u, 0u, 0u};
        if (rr >= 0 && rr < SEQ) ring[k] = *(const u32x4*)(ub + (size_t)rr * 4096);
        float v[8]; unpack8(ring[k], v);
#pragma unroll
        for (int e = 0; e < 8; ++e) sum[e] += v[e]; }
    for (int sb = s0; sb < s0 + 64; sb += 2 * H) {
#pragma unroll
        for (int t = 0; t < 2 * H; ++t) {
            const int s = sb + t;
            const int lo = (s - H) > 0 ? (s - H) : 0, hi = (s + H) < SEQ ? (s + H) : SEQ;
            const float inv = __builtin_amdgcn_rcpf((float)(hi - lo));
            const u32x4 gw = *(const u32x4*)(ub + (size_t)s * 4096 + 2048);
            u32x4 nw = (u32x4){0u, 0u, 0u, 0u}; if (s + H < SEQ) nw = *(const u32x4*)(ub + (size_t)(s + H) * 4096);
            float cv[8], gv[8], o[8], av[8], bv[8]; unpack8(ring[(t + H) % (2 * H)], cv); unpack8(gw, gv); unpack8(nw, av); unpack8(ring[t], bv);
#pragma unroll
            for (int e = 0; e < 8; ++e) { const float d = sum[e] * inv - cv[e]; o[e] = d * sc[e] * silu_f(gv[e]); }
            *(u32x4*)(db + (size_t)s * 2048) = pack8(o);
#pragma unroll
            for (int e = 0; e < 8; ++e) sum[e] += av[e] - bv[e];
            ring[t] = nw;
        }
    }
}
__device__ __forceinline__ void pool_mix_phase(const int tid, const bf16_t* mg, const float* scale, bf16_t* y) {
    const int total = HB * 64 * 256;
    for (int id = blockIdx.x * 512 + tid; id < total; id += gridDim.x * 512) {
        const int chunk = id & 255, run = (id >> 8) & 63, b = id >> 14;
        const int g = chunk >> 6;
        const bf16_t* ub = mg + (size_t)(b * SEQ) * 4096 + chunk * 8;
        bf16_t* db = y + (size_t)(b * SEQ) * 2048 + chunk * 8;
        const f32x4 sc0 = *(const f32x4*)(scale + chunk * 8), sc1 = *(const f32x4*)(scale + chunk * 8 + 4);
        const float sc[8] = {sc0[0], sc0[1], sc0[2], sc0[3], sc1[0], sc1[1], sc1[2], sc1[3]};
        const int s0 = run * 64;
        if (g == 0) pool_mix_run<1>(ub, db, sc, s0); else if (g == 1) pool_mix_run<2>(ub, db, sc, s0); else if (g == 2) pool_mix_run<4>(ub, db, sc, s0); else pool_mix_run<8>(ub, db, sc, s0);
    }
}

struct AttItem { int b, g, head, r, n0, dsh; };
__device__ __forceinline__ AttItem att_decode(int item) {
    AttItem it; const int pairidx = item & 31; it.head = (item >> 5) & 7; const int bg = item >> 8; it.g = bg % 3; it.b = bg / 3;
    it.dsh = 2 * it.g; const int ppr = 32 >> it.dsh; it.r = pairidx / ppr; it.n0 = 2 * (pairidx - it.r * ppr); return it;
}
__device__ __forceinline__ void att_load_half(const AttItem& it, const int tid, const bf16_t* proj, const float* cosT, const float* sinT, const int I0,
                                              u32x4 (&kvs)[4], u32x4 (&vvs)[4], f32x4 (&kct)[2], f32x4 (&kst)[2]) {
    const int ch = tid & 15, rowb = tid >> 4, dil = 1 << it.dsh, nsub = 4096 >> it.dsh;
    const bf16_t* base = proj + (size_t)(it.b * SEQ) * 10240 + it.g * 3072 + it.head * 128;
#pragma unroll
    for (int i4 = 0; i4 < 4; ++i4) {
        const int jk = (it.n0 - 1) * 64 + rowb + 32 * (I0 + i4); const bool valid = (jk >= 0) && (jk < nsub);
        kvs[i4] = (u32x4){0u, 0u, 0u, 0u}; vvs[i4] = (u32x4){0u, 0u, 0u, 0u};
        if (valid) { const bf16_t* p = base + (size_t)(jk * dil + it.r) * 10240; kvs[i4] = *(const u32x4*)(p + 1024 + ch * 8); vvs[i4] = *(const u32x4*)(p + 2048 + ch * 8); }
    }
    const int pb = ((it.n0 - 1) * 64 + rowb + 32 * I0) * dil + it.r, pa = pb < 0 ? -pb : pb;
#pragma unroll
    for (int hh = 0; hh < 2; ++hh) { kct[hh] = *(const f32x4*)(cosT + pa * 16 + (ch & 1) * 8 + 4 * hh); kst[hh] = *(const f32x4*)(sinT + pa * 16 + (ch & 1) * 8 + 4 * hh); }
}
__device__ __forceinline__ void att_load_q(const AttItem& it, const int tid, const bf16_t* proj, u32x4 (&qraw)[4]) {
    const int dil = 1 << it.dsh, lane = tid & 63, fr = lane & 15, fq = lane >> 4, ql = (tid >> 6) * 16 + fr, posq = (it.n0 * 64 + ql) * dil + it.r;
    const bf16_t* qp = proj + (size_t)(it.b * SEQ) * 10240 + it.g * 3072 + it.head * 128 + (size_t)posq * 10240;
#pragma unroll
    for (int s = 0; s < 4; ++s) qraw[s] = *(const u32x4*)(qp + 32 * s + 8 * fq);
}

__device__ __forceinline__ void attn_phase(const int tid_in, LAS unsigned char* lds, bf16_t* proj, float* lse, const float* qn, const float* kn, const float* cosT, const float* sinT) {
    LAS unsigned char* Kimg = lds; LAS unsigned char* Vimg = lds + 65536;
    const int nitems = HB * 3 * 8 * 32;
    LAS float* gq = (LAS float*)(lds + 131072); LAS float* gk = gq + 384; LAS float* dtab = gk + 384;
    if (tid_in < 384) { gq[tid_in] = qn[tid_in]; gk[tid_in] = kn[tid_in]; }
    if (tid_in < 96) { const int gg = tid_in >> 5, i = tid_in & 31; dtab[tid_in] = (i < 16) ? cosT[(32 << (2 * gg)) * 16 + i] : sinT[(32 << (2 * gg)) * 16 + (i - 16)]; }
    __syncthreads();
    const int tid = tid_in, w = tid >> 6, lane = tid & 63, fr = lane & 15, fq = lane >> 4;
    LAS const unsigned char* kbase[2][4]; LAS const unsigned char* vb2[2]; unsigned xe2[2];
#pragma unroll
    for (int h = 0; h < 2; ++h)
#pragma unroll
        for (int s = 0; s < 4; ++s) kbase[h][s] = Kimg + off_b(8 * (fr >> 2) + 4 * h + (fr & 3), 4 * s + fq);
#pragma unroll
    for (int t = 0; t < 2; ++t) { const unsigned q = (lane & 15) >> 2, p = lane & 3, Xt = (q << 2) | ((2 * fq + t) & 3);
        vb2[t] = Vimg + 256 * (8 * fq + 4 * t + q) + 16 * ((p >> 1) ^ (Xt & 1)) + 8 * (p & 1); xe2[t] = Xt >> 1; }
    const int per_blk = (nitems + (int)gridDim.x - 1) / (int)gridDim.x, item_lo = (int)blockIdx.x * per_blk, item_hi = (item_lo + per_blk) < nitems ? (item_lo + per_blk) : nitems;
    for (int item = item_lo; item < item_hi; ++item) {
        const AttItem it = att_decode(item);
        const int head = it.head, g = it.g, b = it.b, r = it.r, n0 = it.n0, dsh = it.dsh, dil = 1 << dsh, nsub = 4096 >> dsh;
        const bool cont = (item > item_lo) && (n0 != 0);
        u32x4 kvs[4], vvs[4], qraw[4]; f32x4 kct[2], kst[2];
        att_load_q(it, tid, proj, qraw);
        att_load_half(it, tid, proj, cosT, sinT, 4, kvs, vvs, kct, kst);
        const int p0 = __builtin_amdgcn_readfirstlane((n0 - 1 + (w >> 2)) & 3);
        const int offj[3] = {16384 * p0, 16384 * ((p0 + 1) & 3), 16384 * ((p0 + 2) & 3)};
        bf16_t* base = proj + (size_t)(b * SEQ) * 10240 + g * 3072 + head * 128;
        const int ch = tid & 15, rowb = tid >> 4;
        const int ql = w * 16 + fr, jq = n0 * 64 + ql, posq = jq * dil + r;
        bf16_t* qp = base + (size_t)posq * 10240;
        const int pbase = ((n0 - 1) * 64 + rowb) * dil + r, pabs = pbase < 0 ? -pbase : pbase;
        f32x4 wkv[2], kcd[2], ksd[2], qc[2], qs[2];
#pragma unroll
        for (int hh = 0; hh < 2; ++hh) {
            qc[hh] = *(const f32x4*)(cosT + posq * 16 + (fq & 1) * 8 + 4 * hh); qs[hh] = *(const f32x4*)(sinT + posq * 16 + (fq & 1) * 8 + 4 * hh);
            wkv[hh] = *(const LAS f32x4*)(gk + g * 128 + ch * 8 + 4 * hh);
            kcd[hh] = *(const LAS f32x4*)(dtab + g * 32 + (ch & 1) * 8 + 4 * hh); ksd[hh] = *(const LAS f32x4*)(dtab + g * 32 + 16 + (ch & 1) * 8 + 4 * hh);
        }
        bf16x8 qfrag[4];
        {
            float qf[4][8]; float ss = 0.f;
#pragma unroll
            for (int s = 0; s < 4; ++s) { unpack8(qraw[s], qf[s]);
#pragma unroll
                for (int e = 0; e < 8; ++e) ss += qf[s][e] * qf[s][e]; }
            ss = xrow16_sum(ss);
            const float rstd = __builtin_amdgcn_rsqf(ss * (1.0f / 128.0f) + EPS);
#pragma unroll
            for (int s = 0; s < 4; ++s)
#pragma unroll
                for (int e = 0; e < 8; ++e) qf[s][e] = qf[s][e] * rstd * gq[g * 128 + 32 * s + 8 * fq + e];
#pragma unroll
            for (int e = 0; e < 8; ++e) { const float pr = lane_xor32(qf[0][e], fq < 2); const float c = qc[e >> 2][e & 3], sn = qs[e >> 2][e & 3];
                qf[0][e] = (fq < 2) ? (qf[0][e] * c - pr * sn) : (qf[0][e] * c + pr * sn); }
            const float sc = 0.08838834764831845f * 1.4426950408889634f;
#pragma unroll
            for (int s = 0; s < 4; ++s) {
#pragma unroll
                for (int e = 0; e < 8; ++e) qf[s][e] *= sc;
                qfrag[s] = __builtin_bit_cast(bf16x8, pack8(qf[s])); }
        }
#define ATT_STAGE_HALF(I0, CC0, SS0, NEG) { float cc[8], sn[8]; \
            _Pragma("unroll") for (int e = 0; e < 8; ++e) { cc[e] = CC0[e >> 2][e & 3]; sn[e] = (NEG) ? -SS0[e >> 2][e & 3] : SS0[e >> 2][e & 3]; } \
            _Pragma("unroll") for (int i = (I0); i < (I0) + 4; ++i) { \
                if ((i & 1) == 0) __builtin_amdgcn_sched_barrier(0); \
                const int slot = (n0 - 1 + (i >> 1)) & 3; \
                float x[8]; unpack8(kvs[i - (I0)], x); \
                float ss = 0.f; \
                _Pragma("unroll") for (int e = 0; e < 8; ++e) ss += x[e] * x[e]; \
                ss = row16_sum(ss); \
                const float rstd = __builtin_amdgcn_rsqf(ss * (1.0f / 128.0f) + EPS); \
                _Pragma("unroll") for (int e = 0; e < 8; ++e) x[e] = x[e] * rstd * wkv[e >> 2][e & 3]; \
                _Pragma("unroll") for (int e = 0; e < 8; ++e) { const float pr = dpp_f<0x4E>(x[e]); const float rot = (ch < 2) ? (x[e] * cc[e] - pr * sn[e]) : (x[e] * cc[e] + pr * sn[e]); x[e] = (ch < 4) ? rot : x[e]; } \
                *(LAS u32x4*)(Kimg + 16384 * slot + off_b(rowb + 32 * (i & 1), ch)) = pack8(x); \
                *(LAS u32x4*)(Vimg + 16384 * slot + off_b(rowb + 32 * (i & 1), ch)) = vvs[i - (I0)]; \
                _Pragma("unroll") for (int e = 0; e < 8; ++e) { const float cd = kcd[e >> 2][e & 3], sd = ksd[e >> 2][e & 3]; const float c2 = cc[e] * cd - sn[e] * sd, s2 = sn[e] * cd + cc[e] * sd; cc[e] = c2; sn[e] = s2; } } }
        ATT_STAGE_HALF(4, kct, kst, false)
        if (!cont) { att_load_half(it, tid, proj, cosT, sinT, 0, kvs, vvs, kct, kst); ATT_STAGE_HALF(0, kct, kst, pbase < 0) }
#undef ATT_STAGE_HALF
        __syncthreads();
        const int mskip = __builtin_amdgcn_readfirstlane(((w & 3) < 2) ? 5 : 0);
        f32x4 sacc[12];
#pragma unroll
        for (int tt = 0; tt < 12; ++tt) {
            if ((tt & 1) == 0) __builtin_amdgcn_sched_barrier(0);
            sacc[tt] = (f32x4){0.f, 0.f, 0.f, 0.f};
            if ((tt >> 1) != mskip)
#pragma unroll
            for (int s = 0; s < 4; ++s) { const bf16x8 kf = *(const LAS bf16x8*)(kbase[tt & 1][s] + offj[tt >> 2] + 8192 * ((tt >> 1) & 1)); sacc[tt] = mfma16(kf, qfrag[s], sacc[tt]); }
        }
        const int jkb = (n0 - 1) * 64 + (w >> 2) * 64, qlw = (w & 3) * 16 + fr;
        const int lo2 = (qlw > -jkb ? qlw : -jkb) - 8 * fq, hi2 = ((qlw + 128) < (nsub - 1 - jkb) ? (qlw + 128) : (nsub - 1 - jkb)) - 8 * fq;
        float mx = -3.0e38f;
#pragma unroll
        for (int tt = 0; tt < 12; ++tt)
#pragma unroll
            for (int j = 0; j < 4; ++j) { const int kc = 32 * (tt >> 1) + 4 * (tt & 1) + j;
                const bool ok = (kc >= lo2) && (kc <= hi2);
                const float v = ok ? sacc[tt][j] : -1.0e30f; sacc[tt][j] = v; mx = fmaxf(mx, v); }
        mx = xrow16_max(mx);
        float sum = 0.f;
#pragma unroll
        for (int tt = 0; tt < 12; ++tt)
#pragma unroll
            for (int j = 0; j < 4; ++j) { const float p = __builtin_amdgcn_exp2f(sacc[tt][j] - mx); sacc[tt][j] = p; sum += p; }
        sum = xrow16_sum(sum);
        bf16x8 pfrag[6];
#pragma unroll
        for (int m = 0; m < 6; ++m) { u32x4 pw; pw.x = cvt_pk_bf16(sacc[2 * m][0], sacc[2 * m][1]); pw.y = cvt_pk_bf16(sacc[2 * m][2], sacc[2 * m][3]);
            pw.z = cvt_pk_bf16(sacc[2 * m + 1][0], sacc[2 * m + 1][1]); pw.w = cvt_pk_bf16(sacc[2 * m + 1][2], sacc[2 * m + 1][3]); pfrag[m] = __builtin_bit_cast(bf16x8, pw); }
        f32x4 oacc[8];
#pragma unroll
        for (int c = 0; c < 8; ++c) oacc[c] = (f32x4){0.f, 0.f, 0.f, 0.f};
#pragma unroll
        for (int ks = 0; ks < 6; ++ks)
            if (ks != mskip)
#pragma unroll
            for (int c = 0; c < 8; ++c) {
                if ((c & 3) == 0) __builtin_amdgcn_sched_barrier(0);
                const s16x4 lo = __builtin_amdgcn_ds_read_tr16_b64_v4i16((LAS s16x4*)(vb2[0] + 32 * (c ^ xe2[0]) + offj[ks >> 1] + 8192 * (ks & 1))), hi = __builtin_amdgcn_ds_read_tr16_b64_v4i16((LAS s16x4*)(vb2[1] + 32 * (c ^ xe2[1]) + offj[ks >> 1] + 8192 * (ks & 1)));
                bf16x8 vf; vf[0] = lo[0]; vf[1] = lo[1]; vf[2] = lo[2]; vf[3] = lo[3]; vf[4] = hi[0]; vf[5] = hi[1]; vf[6] = hi[2]; vf[7] = hi[3];
                oacc[c] = mfma16(vf, pfrag[ks], oacc[c]); }
        const float inv = __builtin_amdgcn_rcpf(sum);
#pragma unroll
        for (int c = 0; c < 8; ++c) { const f32x4 o = oacc[c] * inv; u32x2 pw; pw.x = cvt_pk_bf16(o[0], o[1]); pw.y = cvt_pk_bf16(o[2], o[3]); *(u32x2*)(qp + 16 * c + 4 * fq) = pw; }
        if (fq == 0) lse[(size_t)(b * SEQ + posq) * 24 + g * 8 + head] = (mx + log2f(sum)) * 0.6931471805599453f;
        __syncthreads();
    }
}

__device__ __forceinline__ void attn_combine_phase(const int tid, bf16_t* proj, const float* lse) {
    const int lane = tid & 63, gw = blockIdx.x * 8 + (tid >> 6), nw = gridDim.x * 8;
    if (((MH * 2) % (2 * nw)) != 0) return;
    for (int task0 = gw; task0 < MH * 2; task0 += 2 * nw) {
        u32x4 ra[2], rb[2], rc[2], rg[2]; float l0[2], l1[2], l2[2];
#pragma unroll
        for (int t2 = 0; t2 < 2; ++t2) { const int task = task0 + t2 * nw, row = task >> 1, head = (task & 1) * 4 + (lane >> 4), d0 = (lane & 15) * 8;
            const bf16_t* p = proj + (size_t)row * 10240 + head * 128 + d0; const float* lp = lse + (size_t)row * 24 + head;
            ra[t2] = *(const u32x4*)(p); rb[t2] = *(const u32x4*)(p + 3072); rc[t2] = *(const u32x4*)(p + 6144); rg[t2] = *(const u32x4*)(proj + (size_t)row * 10240 + 9216 + head * 128 + d0);
            l0[t2] = lp[0]; l1[t2] = lp[8]; l2[t2] = lp[16]; }
#pragma unroll
        for (int t2 = 0; t2 < 2; ++t2) { const int task = task0 + t2 * nw, row = task >> 1, head = (task & 1) * 4 + (lane >> 4), d0 = (lane & 15) * 8;
            const float m = fmaxf(l0[t2], fmaxf(l1[t2], l2[t2]));
            float w0 = __expf(l0[t2] - m), w1 = __expf(l1[t2] - m), w2 = __expf(l2[t2] - m);
            const float inv = __builtin_amdgcn_rcpf(w0 + w1 + w2); w0 *= inv; w1 *= inv; w2 *= inv;
            float a[8], bq[8], c[8], gt[8], o[8];
            unpack8(ra[t2], a); unpack8(rb[t2], bq); unpack8(rc[t2], c); unpack8(rg[t2], gt);
#pragma unroll
            for (int e = 0; e < 8; ++e) { const float y = w0 * a[e] + w1 * bq[e] + w2 * c[e]; o[e] = y * silu_f(gt[e]); }
            *(u32x4*)(proj + (size_t)row * 10240 + head * 128 + d0) = pack8(o); }
    }
}

__device__ __forceinline__ void ret_chain_phase(int tid, LAS unsigned char* lds, const bf16_t* proj, bf16_t* outbuf, const float* decay) {
    const int w = tid >> 6, lane = tid & 63, fr = lane & 15, fq = lane >> 4;
    LAS unsigned char* R1 = lds; LAS unsigned char* RV = lds + 65536;
    for (int item = blockIdx.x; item < HB * 32; item += gridDim.x) {
        const int vs = item & 3, dir = (item >> 2) & 1, h = (item >> 3) & 3, b = item >> 5;
        asm volatile("" : "+v"(tid)); const int ti = tid;
        const int w = ti >> 6, fr = ti & 15, fq = (ti & 63) >> 4;
        const float lg2 = log2f(1.0f - exp2f(-decay[dir * 4 + h]));
        const float gC = exp2f(128.0f * lg2);
        const int ql = w * 16 + fr;
        const float qd = exp2f(lg2 * (float)(dir ? (128 - ql) : (ql + 1)));
        const float rs = exp2f(lg2 * (float)(dir ? (-ql) : (ql - 127)));
        const float kd0 = exp2f(lg2 * (float)(dir ? (ti >> 5) : (127 - (ti >> 5)))), kdstep = exp2f(lg2 * (dir ? 16.0f : -16.0f));
        const int qlo = dir ? (ql + 1) : 0, qhi = dir ? 127 : ql;
        const int lo2 = qlo - 8 * fq, hi2 = qhi - 8 * fq;
        f32x4 st[2][8];
#pragma unroll
        for (int rt = 0; rt < 2; ++rt)
#pragma unroll
            for (int c = 0; c < 8; ++c) st[rt][c] = (f32x4){0.f, 0.f, 0.f, 0.f};
        const int qcol = (dir ? 2048 : 0) + h * 256, kcol = (dir ? 3072 : 1024) + h * 256, vcol = 4096 + h * 512 + vs * 128;
        bf16x8 qfrag[8];
        { const bf16_t* qp0 = proj + (size_t)(b * SEQ + (dir ? 31 : 0) * 128 + ql) * 8192 + qcol;
#pragma unroll
            for (int s = 0; s < 8; ++s) qfrag[s] = *(const bf16x8*)(qp0 + 32 * s + 8 * fq); }
        for (int step = 0; step < 32; ++step) {
            const int cidx = dir ? (31 - step) : step, row0 = b * SEQ + cidx * 128;
            asm volatile("" : "+v"(tid)); const int tz = tid;
            const int zw = tz >> 6, zl = tz & 63, zfr = zl & 15, zfq = zl >> 4;
            const int w = zw, fr = zfr, fq = zfq, ql = zw * 16 + zfr; const unsigned xs = zfr & 3;
            LAS const unsigned char* sb1 = R1 + off_b(zfr, zfq ^ (4 * xs));
            LAS const unsigned char* kb1[2]; LAS const unsigned char* vb2[2]; unsigned xe2[2];
#pragma unroll
            for (int hh = 0; hh < 2; ++hh) kb1[hh] = R1 + off_b(8 * (zfr >> 2) + 4 * hh + (zfr & 3), zfq ^ (4 * xs));
#pragma unroll
            for (int t = 0; t < 2; ++t) { const unsigned q = (unsigned)zfr >> 2, pp = zfr & 3, Xt = (q << 2) | ((2 * zfq + t) & 3);
                vb2[t] = RV + 256 * (8 * zfq + 4 * t + q) + 16 * ((pp >> 1) ^ (Xt & 1)) + 8 * (pp & 1); xe2[t] = Xt >> 1; }
            LAS const unsigned char* ktb[2][2]; LAS unsigned char* swb[2];
#pragma unroll
            for (int rt = 0; rt < 2; ++rt) { swb[rt] = R1 + (zw >> 2) * 32768 + off_b(zfr, 4 * (zw & 3) + 2 * rt + (zfq >> 1)) + 8 * (zfq & 1);
#pragma unroll
                for (int t = 0; t < 2; ++t) ktb[rt][t] = R1 + (zw >> 2) * 32768 + tr_addr16(zl, 2 * (zw & 3) + rt, 0, t); }
            LAS unsigned char* kwb = R1 + ((tz & 31) >> 4) * 32768 + off_b(tz >> 5, tz & 15);
            LAS unsigned char* vwb = RV + off_b(tz >> 4, tz & 15);
            u32x4 kraw[8], vraw[4];
            const bf16_t* kg = proj + (size_t)(row0 + (tz >> 5)) * 8192 + kcol + (tz & 31) * 8;
            const bf16_t* vg = proj + (size_t)(row0 + (tz >> 4)) * 8192 + vcol + (tz & 15) * 8;
#pragma unroll
            for (int i = 0; i < 4; ++i) kraw[i] = *(const u32x4*)(kg + (size_t)i * 16 * 8192);
            f32x4 oacc[8];
#pragma unroll
            for (int c = 0; c < 8; ++c) oacc[c] = (f32x4){0.f, 0.f, 0.f, 0.f};
            if (step > 0) {
                bf16x8 fbuf[2][4];
#define QS_LOAD(G, BUF) { _Pragma("unroll") for (int j = 0; j < 4; ++j) { const int n = 4 * (G) + j, c = n >> 3, s = n & 7; fbuf[BUF][j] = *(const LAS bf16x8*)(sb1 + 64 * ((s & 3) ^ xs) + 4096 * c + 32768 * (s >> 2)); } }
                QS_LOAD(0, 0)
#pragma unroll
                for (int g = 0; g < 16; ++g) {
                    if (g + 1 < 16) QS_LOAD(g + 1, (g + 1) & 1)
                    __builtin_amdgcn_sched_barrier(0);
#pragma unroll
                    for (int j = 0; j < 4; ++j) { const int n = 4 * g + j, c = n >> 3, s = n & 7; oacc[c] = mfma16(fbuf[g & 1][j], qfrag[s], oacc[c]); }
                    __builtin_amdgcn_sched_barrier(0);
                }
#undef QS_LOAD
#pragma unroll
                for (int c = 0; c < 8; ++c) oacc[c] = oacc[c] * qd;
            }
#pragma unroll
            for (int i = 4; i < 8; ++i) kraw[i] = *(const u32x4*)(kg + (size_t)i * 16 * 8192);
            __syncthreads();
#pragma unroll
            for (int i = 0; i < 4; ++i) vraw[i] = *(const u32x4*)(vg + (size_t)i * 32 * 8192);
            { float kd = kd0;
#pragma unroll
              for (int i = 0; i < 8; ++i) {
                float x[8]; unpack8(kraw[i], x);
#pragma unroll
                for (int e = 0; e < 8; ++e) x[e] *= kd;
                *(LAS u32x4*)(kwb + 4096 * i) = pack8(x); kd *= kdstep; } }
#pragma unroll
            for (int i = 0; i < 4; ++i) *(LAS u32x4*)(vwb + 8192 * i) = vraw[i];
            __syncthreads();
            f32x4 sacc[8];
#pragma unroll
            for (int tt = 0; tt < 8; ++tt) sacc[tt] = (f32x4){0.f, 0.f, 0.f, 0.f};
            {
                bf16x8 fbuf[2][4];
#define ST_LOAD(G, BUF) { _Pragma("unroll") for (int j = 0; j < 4; ++j) { const int n = 4 * (G) + j, tt = n >> 3, s = n & 7; fbuf[BUF][j] = *(const LAS bf16x8*)(kb1[tt & 1] + 64 * ((s & 3) ^ xs) + 8192 * (tt >> 1) + 32768 * (s >> 2)); } }
                ST_LOAD(0, 0)
#pragma unroll
                for (int g = 0; g < 16; ++g) {
                    if (g + 1 < 16) ST_LOAD(g + 1, (g + 1) & 1)
                    __builtin_amdgcn_sched_barrier(0);
#pragma unroll
                    for (int j = 0; j < 4; ++j) { const int n = 4 * g + j, tt = n >> 3, s = n & 7; sacc[tt] = mfma16(fbuf[g & 1][j], qfrag[s], sacc[tt]); }
                    __builtin_amdgcn_sched_barrier(0);
                }
#undef ST_LOAD
            }
            bf16x8 pfrag[4];
#pragma unroll
            for (int m = 0; m < 4; ++m) { float pv[8];
#pragma unroll
                for (int i = 0; i < 8; ++i) { const int kc = 32 * m + i; const bool keep = (kc >= lo2) && (kc <= hi2);
                    pv[i] = keep ? sacc[2 * m + (i >> 2)][i & 3] * rs : 0.f; }
                pfrag[m] = __builtin_bit_cast(bf16x8, pack8(pv)); }
#pragma unroll
            for (int rt = 0; rt < 2; ++rt)
#pragma unroll
                for (int c = 0; c < 8; ++c) st[rt][c] = st[rt][c] * gC;
            if (step < 31) { const int ncidx = dir ? (30 - step) : (step + 1); const bf16_t* qpn = proj + (size_t)(b * SEQ + ncidx * 128 + (tz >> 6) * 16 + ((tz & 63) & 15)) * 8192 + qcol + 8 * ((tz & 63) >> 4);
#pragma unroll
                for (int s = 0; s < 8; ++s) qfrag[s] = *(const bf16x8*)(qpn + 32 * s); }
            {
                bf16x8 vfb[2][2], ktq[2][2];
#define TR8(PTR_LO, PTR_HI, DST) { const s16x4 lo_ = __builtin_amdgcn_ds_read_tr16_b64_v4i16((LAS s16x4*)(PTR_LO)), hi_ = __builtin_amdgcn_ds_read_tr16_b64_v4i16((LAS s16x4*)(PTR_HI)); \
        DST[0] = lo_[0]; DST[1] = lo_[1]; DST[2] = lo_[2]; DST[3] = lo_[3]; DST[4] = hi_[0]; DST[5] = hi_[1]; DST[6] = hi_[2]; DST[7] = hi_[3]; }
#define VF_LOAD(G, BUF) { _Pragma("unroll") for (int j = 0; j < 2; ++j) { const int ks = (G) >> 2, c = 2 * ((G) & 3) + j; TR8(vb2[0] + 32 * (c ^ xe2[0]) + 8192 * ks, vb2[1] + 32 * (c ^ xe2[1]) + 8192 * ks, vfb[BUF][j]) } }
#define KT_LOAD(KS, BUF) { _Pragma("unroll") for (int rt = 0; rt < 2; ++rt) TR8(ktb[rt][0] + 8192 * (KS), ktb[rt][1] + 8192 * (KS), ktq[BUF][rt]) }
                KT_LOAD(0, 0) VF_LOAD(0, 0)
#pragma unroll
                for (int g = 0; g < 16; ++g) {
                    if (g + 1 < 16) VF_LOAD(g + 1, (g + 1) & 1)
                    if ((g & 3) == 3 && g + 1 < 16) KT_LOAD((g + 1) >> 2, ((g + 1) >> 2) & 1)
                    __builtin_amdgcn_sched_barrier(0);
#pragma unroll
                    for (int j = 0; j < 2; ++j) { const int ks = g >> 2, c = 2 * (g & 3) + j;
                        oacc[c] = mfma16(vfb[g & 1][j], pfrag[ks], oacc[c]); st[0][c] = mfma16(ktq[ks & 1][0], vfb[g & 1][j], st[0][c]); st[1][c] = mfma16(ktq[ks & 1][1], vfb[g & 1][j], st[1][c]); }
                    __builtin_amdgcn_sched_barrier(0);
                }
#undef VF_LOAD
#undef KT_LOAD
#undef TR8
            }
            { bf16_t* op = outbuf + (size_t)dir * MH * 2048 + (size_t)(row0 + ql) * 2048 + h * 512 + vs * 128;
#pragma unroll
                for (int c = 0; c < 8; ++c) { u32x2 pw; pw.x = cvt_pk_bf16(oacc[c][0], oacc[c][1]); pw.y = cvt_pk_bf16(oacc[c][2], oacc[c][3]); *(u32x2*)(op + 16 * c + 4 * fq) = pw; } }
            __syncthreads();
#pragma unroll
            for (int rt = 0; rt < 2; ++rt)
#pragma unroll
                for (int c = 0; c < 8; ++c) { u32x2 pw; pw.x = cvt_pk_bf16(st[rt][c][0], st[rt][c][1]); pw.y = cvt_pk_bf16(st[rt][c][2], st[rt][c][3]);
                    *(LAS u32x2*)(swb[rt] + 4096 * c) = pw; }
            __syncthreads();
        }
    }
}

__device__ __forceinline__ void ret_combine_phase(const int tid, bf16_t* proj, const bf16_t* outbuf) {
    const int lane = tid & 63, gw = blockIdx.x * 8 + (tid >> 6), nw = gridDim.x * 8;
    if (((MH * 4) % (2 * nw)) != 0) return;
    for (int task0 = gw; task0 < MH * 4; task0 += 2 * nw) {
        u32x4 ra[2], rb[2], rg[2];
#pragma unroll
        for (int t2 = 0; t2 < 2; ++t2) { const int task = task0 + t2 * nw, row = task >> 2, h = task & 3, col = h * 512 + lane * 8;
            ra[t2] = *(const u32x4*)(outbuf + (size_t)row * 2048 + col); rb[t2] = *(const u32x4*)(outbuf + (size_t)MH * 2048 + (size_t)row * 2048 + col);
            rg[t2] = *(const u32x4*)(proj + (size_t)row * 8192 + 6144 + col); }
#pragma unroll
        for (int t2 = 0; t2 < 2; ++t2) { const int task = task0 + t2 * nw, row = task >> 2, h = task & 3, col = h * 512 + lane * 8;
            float a[8], bq[8], gt[8], o[8]; unpack8(ra[t2], a); unpack8(rb[t2], bq); unpack8(rg[t2], gt);
            float ss = 0.f;
#pragma unroll
            for (int e = 0; e < 8; ++e) { a[e] += bq[e]; ss += a[e] * a[e]; }
            ss = wave_sum(ss);
            const float rstd = __builtin_amdgcn_rsqf(ss * (1.0f / 512.0f) + EPS);
#pragma unroll
            for (int e = 0; e < 8; ++e) o[e] = a[e] * rstd * silu_f(gt[e]);
            *(u32x4*)(proj + (size_t)row * 8192 + col) = pack8(o); }
    }
}

__device__ __forceinline__ void grid_barrier(unsigned* ctr, unsigned target) {
    asm volatile("s_waitcnt vmcnt(0) lgkmcnt(0)" ::: "memory");
    __syncthreads();
    if (threadIdx.x < 64) {
        asm volatile("buffer_wbl2 sc1\n\ts_waitcnt vmcnt(0)" ::: "memory");
        if (threadIdx.x == 0) {
            __hip_atomic_fetch_add(ctr, 1u, __ATOMIC_RELAXED, __HIP_MEMORY_SCOPE_AGENT);
            while (__hip_atomic_load(ctr, __ATOMIC_RELAXED, __HIP_MEMORY_SCOPE_AGENT) < target) __builtin_amdgcn_s_sleep(2);
        }
        asm volatile("buffer_inv sc1\n\ts_waitcnt vmcnt(0)" ::: "memory");
    }
    __syncthreads();
}

#define PH_N 28
static __device__ const unsigned char PH_TAB[PH_N] = {1, 2, 4, 9, 10, 12, 17, 18, 19, 20, 25, 26, 27, 28, 33, 34, 35, 36, 41, 42, 43, 44, 49, 50, 52, 57, 58, 60};

__global__ void __launch_bounds__(512, 2) mega_fwd(Params p) {
    extern __shared__ __attribute__((aligned(16))) unsigned char smem[];
    LAS unsigned char* lds = (LAS unsigned char*)smem;
    cg::grid_group grid = cg::this_grid();
    unsigned char* ws = p.ws;
    bf16_t* wt_pool_in = (bf16_t*)(ws + WS_WT_POOL_IN); bf16_t* wt_pool_g = (bf16_t*)(ws + WS_WT_POOL_G); bf16_t* wt_pool_out = (bf16_t*)(ws + WS_WT_POOL_OUT);
    bf16_t* wt_att_in = (bf16_t*)(ws + WS_WT_ATT_IN); bf16_t* wt_att_out = (bf16_t*)(ws + WS_WT_ATT_OUT);
    bf16_t* wt_ret_in = (bf16_t*)(ws + WS_WT_RET_IN); bf16_t* wt_ret_out = (bf16_t*)(ws + WS_WT_RET_OUT);
    float* ret_cos = (float*)(ws + WS_RET_COS); float* ret_sin = (float*)(ws + WS_RET_SIN); float* att_cos = (float*)(ws + WS_ATT_COS); float* att_sin = (float*)(ws + WS_ATT_SIN);
    float* lse = (float*)(ws + WS_LSE); bf16_t* hbuf = (bf16_t*)(ws + WS_H); bf16_t* proj = (bf16_t*)(ws + WS_PROJ);
    bf16_t* pool_diff = (bf16_t*)(ws + WS_PROJ + 256 * MiB); bf16_t* ret_out = (bf16_t*)(ws + WS_PROJ + 512 * MiB);

    unsigned* bar_ctr = (unsigned*)(ws + WS_END); unsigned bar_n = 0;
    grid.sync();
    int tid0 = threadIdx.x; asm volatile("" : "+v"(tid0));
    transpose_batch(tid0, lds, p.pool_w_in + 2048, wt_pool_in + (size_t)2048 * 1024, 1024, 2048, 2, 4096, (size_t)1024 * 4096, (size_t)4096 * 1024);
    convert_rows(tid0, p.pool_w_in, pool_diff, 1024, 2048, 4096); convert_rows(tid0, p.pool_w_in + (size_t)1024 * 4096, pool_diff + (size_t)1024 * 2048, 1024, 2048, 4096);
    transpose_batch(tid0, lds, p.pool_w_group, wt_pool_g, 512, 512, 8);
    transpose_batch(tid0, lds, p.pool_w_out, wt_pool_out, 2048, 1024, 2);
    bar_n += gridDim.x; grid_barrier(bar_ctr, bar_n);
    for (int l = 0; l < 2; ++l) { pg8::EpiStore E; E.O = wt_pool_in + (size_t)l * 4096 * 1024; E.ldc = 1024;
        run_gemm(tid0, lds, wt_pool_g + (size_t)l * 2048 * 512, 512, pool_diff + (size_t)l * 1024 * 2048, 2048, 2048, 1024, 512, 0, E, 2); }
    transpose_batch(tid0, lds, p.att_w_in, wt_att_in, 1024, 10240, 1);
    transpose_batch(tid0, lds, p.att_w_out, wt_att_out, 1024, 1024, 1);
    transpose_batch(tid0, lds, p.ret_w_in, wt_ret_in, 1024, 8192, 1);
    transpose_batch(tid0, lds, p.ret_w_out, wt_ret_out, 2048, 1024, 1);
    rope_tables(tid0, ret_cos, ret_sin, att_cos, att_sin);
    rmsnorm_phase(tid0, p.x, p.pool_norm, hbuf);
    bar_n += gridDim.x; grid_barrier(bar_ctr, bar_n);

    for (int ph = 0; ph < PH_N; ++ph) {
        int tid = threadIdx.x; asm volatile("" : "+v"(tid));
        const int code = PH_TAB[ph], lh = code >> 3, sub = code & 7, layer = lh >> 1, half = lh & 1;
        const int kind = layer % 3, idx = layer / 3;
        const size_t xo = (size_t)half * MH * DM;
        if (sub == 0) {
            int lo = layer; asm volatile("" : "+s"(lo));
            const float* xsrc = (lo == 0 ? p.x : p.out) + xo;
            rmsnorm_phase(tid, xsrc, kind == 0 ? p.pool_norm + idx * 1024 : (kind == 1 ? p.att_norm : p.ret_norm), hbuf);
        } else if (sub == 4) {
            const bf16_t* A = kind == 0 ? pool_diff : proj; const int lda = kind == 0 ? 2048 : (kind == 1 ? 10240 : 8192), K = kind == 1 ? 1024 : 2048;
            const bf16_t* Bt = kind == 0 ? wt_pool_out + (size_t)idx * 1024 * 2048 : (kind == 1 ? wt_att_out : wt_ret_out);
            int lo = layer; asm volatile("" : "+s"(lo));
            const float* xsrc = (lo == 0 ? p.x : p.out) + xo; float* xdst = p.out + xo;
            pg8::EpiResid E; E.base = xsrc; E.out = xdst; run_gemm(tid, lds, A, lda, Bt, K, MH, 1024, K, 0, E);
            if (lh + 1 < 8) { int l2 = (lh + 1) >> 1; const int h2 = (lh + 1) & 1, k2 = l2 % 3, i2 = l2 / 3; asm volatile("" : "+s"(l2));
                const float* xs2 = (l2 == 0 ? p.x : p.out) + (size_t)h2 * MH * DM;
                rmsnorm_phase(tid, xs2, k2 == 0 ? p.pool_norm + i2 * 1024 : (k2 == 1 ? p.att_norm : p.ret_norm), hbuf); }
        } else if (sub == 1) {
            if (kind == 2) { pg8::EpiRet E; E.O = proj; E.cosT = ret_cos; E.sinT = ret_sin; run_gemm(tid, lds, hbuf, 1024, wt_ret_in, 1024, MH, 8192, 1024, 0, E); }
            else { const int N = kind == 0 ? 4096 : 10240; const bf16_t* Bt = kind == 0 ? wt_pool_in + (size_t)idx * 4096 * 1024 : wt_att_in;
                pg8::EpiStore E; E.O = proj; E.ldc = N; run_gemm(tid, lds, hbuf, 1024, Bt, 1024, MH, N, 1024, 0, E); }
        } else if (sub == 2) {
            if (kind == 0) pool_mix_phase(tid, proj, p.pool_scale + idx * 2048, pool_diff);
            else if (kind == 1) attn_phase(tid, lds, proj, lse, p.att_q_norm, p.att_k_norm, att_cos, att_sin);
            else ret_chain_phase(tid, lds, proj, ret_out, p.ret_decay);
        } else if (sub == 3) {
            if (kind == 0) { }
            else if (kind == 1) attn_combine_phase(tid, proj, lse);
            else ret_combine_phase(tid, proj, ret_out);
        }
        if (ph + 1 < PH_N) { bar_n += gridDim.x; grid_barrier(bar_ctr, bar_n); }
    }
}

extern "C" void kernel_launch(void* const* d_in, const int* in_sizes, int n_in, void* d_out, int out_size, void* d_ws, size_t ws_size, hipStream_t stream) {
    constexpr int LDS_BYTES = 135168;
    static int grid_blocks = 0;
    if (grid_blocks == 0) {
        if (n_in != 15 || ws_size < WS_END + 256) { fprintf(stderr, "kernel_launch: unexpected n_in %d / ws_size %zu (need %zu)\n", n_in, ws_size, (size_t)WS_END); grid_blocks = -1; return; }
        int dev = 0, cus = 0, per_cu = 0;
        hipGetDevice(&dev);
        hipDeviceGetAttribute(&cus, hipDeviceAttributeMultiprocessorCount, dev);
        if (hipFuncSetAttribute((const void*)mega_fwd, hipFuncAttributeMaxDynamicSharedMemorySize, LDS_BYTES) != hipSuccess) { fprintf(stderr, "kernel_launch: hipFuncSetAttribute failed\n"); }
        hipOccupancyMaxActiveBlocksPerMultiprocessor(&per_cu, (const void*)mega_fwd, 512, LDS_BYTES);
        (void)hipGetLastError();
        if (per_cu < 1) per_cu = 1;
        grid_blocks = cus;
    }
    if (grid_blocks < 0) return;
    (void)hipMemsetAsync((unsigned char*)d_ws + WS_END, 0, 256, stream);
    Params p{};
    p.x = (const float*)d_in[0]; p.pool_norm = (const float*)d_in[1]; p.pool_w_in = (const float*)d_in[2]; p.pool_w_group = (const float*)d_in[3];
    p.pool_scale = (const float*)d_in[4]; p.pool_w_out = (const float*)d_in[5]; p.att_norm = (const float*)d_in[6]; p.att_w_in = (const float*)d_in[7];
    p.att_q_norm = (const float*)d_in[8]; p.att_k_norm = (const float*)d_in[9]; p.att_w_out = (const float*)d_in[10]; p.ret_norm = (const float*)d_in[11];
    p.ret_w_in = (const float*)d_in[12]; p.ret_decay = (const float*)d_in[13]; p.ret_w_out = (const float*)d_in[14];
    p.out = (float*)d_out; p.ws = (unsigned char*)d_ws;
    void* args[] = {&p};
    hipError_t e = hipLaunchCooperativeKernel((const void*)mega_fwd, dim3(grid_blocks), dim3(512), args, LDS_BYTES, stream);
    if (e != hipSuccess) fprintf(stderr, "cooperative launch failed: %s (grid %d)\n", hipGetErrorString(e), grid_blocks);
}
```

```cpp
#include <hip/hip_runtime.h>
#include <hip/hip_cooperative_groups.h>
#include <cstdio>
namespace cg = cooperative_groups;

#define LAS __attribute__((address_space(3)))
typedef unsigned short bf16_t;
typedef short bf16x8 __attribute__((ext_vector_type(8)));
typedef short s16x4 __attribute__((ext_vector_type(4)));
typedef float f32x4 __attribute__((ext_vector_type(4)));
typedef unsigned u32x4 __attribute__((ext_vector_type(4)));
typedef unsigned u32x2 __attribute__((ext_vector_type(2)));

constexpr int SEQ = 4096, DM = 1024, NB = 16;
constexpr int HB = 8;
constexpr int MH = HB * SEQ;
constexpr float EPS = 1e-6f;
constexpr size_t MiB = 1024ull * 1024ull;
constexpr size_t WS_WT_POOL_IN  = 0;
constexpr size_t WS_WT_POOL_G   = 16 * MiB;
constexpr size_t WS_WT_POOL_OUT = 20 * MiB;
constexpr size_t WS_WT_ATT_IN   = 28 * MiB;
constexpr size_t WS_WT_ATT_OUT  = 48 * MiB;
constexpr size_t WS_WT_RET_IN   = 50 * MiB;
constexpr size_t WS_WT_RET_OUT  = 66 * MiB;
constexpr size_t WS_RET_COS     = 70 * MiB;
constexpr size_t WS_RET_SIN     = 72 * MiB;
constexpr size_t WS_ATT_COS     = 74 * MiB;
constexpr size_t WS_ATT_SIN     = 74 * MiB + 512 * 1024;
constexpr size_t WS_LSE         = 75 * MiB;
constexpr size_t WS_H           = 78 * MiB;
constexpr size_t WS_PROJ        = 142 * MiB;
constexpr size_t WS_END         = 142 * MiB + 768 * MiB;

struct Params {
    const float* x; const float* pool_norm; const float* pool_w_in; const float* pool_w_group; const float* pool_scale; const float* pool_w_out;
    const float* att_norm; const float* att_w_in; const float* att_q_norm; const float* att_k_norm; const float* att_w_out;
    const float* ret_norm; const float* ret_w_in; const float* ret_decay; const float* ret_w_out;
    float* out; unsigned char* ws;
};

typedef float f32x2 __attribute__((ext_vector_type(2)));
typedef __bf16 bf16x2_t __attribute__((ext_vector_type(2)));
__device__ __forceinline__ unsigned cvt_pk_bf16(float lo, float hi) { f32x2 v = {lo, hi}; return __builtin_bit_cast(unsigned, __builtin_convertvector(v, bf16x2_t)); }
__device__ __forceinline__ float bf_lo(unsigned w) { return __uint_as_float(w << 16); }
__device__ __forceinline__ float bf_hi(unsigned w) { return __uint_as_float(w & 0xffff0000u); }
__device__ __forceinline__ f32x4 mfma16(bf16x8 a, bf16x8 b, f32x4 c) { return __builtin_amdgcn_mfma_f32_16x16x32_bf16(a, b, c, 0, 0, 0); }
__device__ __forceinline__ float silu_f(float g) { return g * __builtin_amdgcn_rcpf(1.0f + __expf(-g)); }
__device__ __forceinline__ unsigned off_b(unsigned row, unsigned ch) { return 256u * row + 16u * (ch ^ (((row & 3u) << 2) | ((row >> 2) & 3u))); }
__device__ __forceinline__ unsigned tr_addr16(unsigned lane, unsigned c, unsigned ks, unsigned t) {
    const unsigned g = lane >> 4, q = (lane & 15u) >> 2, p = lane & 3u;
    return off_b(32u * ks + 8u * g + 4u * t + q, 2u * c + (p >> 1)) + 8u * (p & 1u);
}
__device__ __forceinline__ bf16x8 tr_read2(unsigned a0, unsigned a1) {
    const s16x4 lo = __builtin_amdgcn_ds_read_tr16_b64_v4i16((LAS s16x4*)a0), hi = __builtin_amdgcn_ds_read_tr16_b64_v4i16((LAS s16x4*)a1);
    bf16x8 r; r[0] = lo[0]; r[1] = lo[1]; r[2] = lo[2]; r[3] = lo[3]; r[4] = hi[0]; r[5] = hi[1]; r[6] = hi[2]; r[7] = hi[3]; return r;
}
template <int CTRL> __device__ __forceinline__ float dpp_f(float x) { return __int_as_float(__builtin_amdgcn_update_dpp(__float_as_int(x), __float_as_int(x), CTRL, 0xF, 0xF, false)); }
__device__ __forceinline__ float row16_sum(float s) { s += dpp_f<0xB1>(s); s += dpp_f<0x4E>(s); s += dpp_f<0x124>(s); s += dpp_f<0x128>(s); return s; }
__device__ __forceinline__ float xrow16_sum(float x) {
    auto s_ = __builtin_amdgcn_permlane16_swap(__float_as_uint(x), __float_as_uint(x), false, false); x = __uint_as_float(s_[0]) + __uint_as_float(s_[1]);
    auto t_ = __builtin_amdgcn_permlane32_swap(__float_as_uint(x), __float_as_uint(x), false, false); return __uint_as_float(t_[0]) + __uint_as_float(t_[1]); }
__device__ __forceinline__ float xrow16_max(float x) {
    auto s_ = __builtin_amdgcn_permlane16_swap(__float_as_uint(x), __float_as_uint(x), false, false); x = fmaxf(__uint_as_float(s_[0]), __uint_as_float(s_[1]));
    auto t_ = __builtin_amdgcn_permlane32_swap(__float_as_uint(x), __float_as_uint(x), false, false); return fmaxf(__uint_as_float(t_[0]), __uint_as_float(t_[1])); }
__device__ __forceinline__ float wave_sum(float x) { return xrow16_sum(row16_sum(x)); }
__device__ __forceinline__ float lane_xor32(float x, bool lower_half) {
    auto t_ = __builtin_amdgcn_permlane32_swap(__float_as_uint(x), __float_as_uint(x), false, false); return lower_half ? __uint_as_float(t_[1]) : __uint_as_float(t_[0]); }
__device__ __forceinline__ u32x4 pack8(const float (&v)[8]) { u32x4 w; w.x = cvt_pk_bf16(v[0], v[1]); w.y = cvt_pk_bf16(v[2], v[3]); w.z = cvt_pk_bf16(v[4], v[5]); w.w = cvt_pk_bf16(v[6], v[7]); return w; }
__device__ __forceinline__ void unpack8(u32x4 w, float (&v)[8]) { v[0] = bf_lo(w.x); v[1] = bf_hi(w.x); v[2] = bf_lo(w.y); v[3] = bf_hi(w.y); v[4] = bf_lo(w.z); v[5] = bf_hi(w.z); v[6] = bf_lo(w.w); v[7] = bf_hi(w.w); }

namespace pg8 {
#define PG8_LAS __attribute__((address_space(3)))
constexpr int BM = 256, BK = 64, HALF = 128, HTB = HALF * BK * 2, STAGE_BYTES = 8 * HTB, NXCD = 8, WGM = 8;
__device__ __forceinline__ int lds_byte(int r, int c) { const int st = (r >> 4) * 2 + (c >> 5), rr = r & 15, cc = c & 31, ob = rr * 64 + cc * 2; return st * 1024 + (ob ^ (((ob >> 9) & 1) << 5)); }
__device__ __forceinline__ void stage_rc(int b, int& R, int& C) { const int st = b / 1024, sb = b % 1024, swz = sb ^ (((sb >> 9) & 1) << 5); R = (st >> 1) * 16 + swz / 64; C = (st & 1) * 32 + (swz % 64) / 2; }
__device__ __forceinline__ int perm32(int rho) { const int n = rho >> 4, i = rho & 15; return 8 * (i >> 2) + 4 * n + (i & 3); }
struct Unit { int pm, pn; };
struct Gemm { const bf16_t* A; const bf16_t* Bt; int M, N, K, lda, ldb, agrp, bgrp; };
struct StaticOrder {
    int nM, nN, nwg, G, c;
    __device__ void init(int M, int N, int G_, int c_) { nM = M / BM; nN = N / BM; nwg = nM * nN; G = G_; c = c_; }
    __device__ bool next(int i, Unit& u) const {
        const long L = (long)i * G + c; if (L >= nwg) return false;
        int wgid = (int)L; { const int q = nwg / NXCD, r = nwg % NXCD, xcd = wgid % NXCD, off = wgid / NXCD; wgid = (xcd < r ? xcd * (q + 1) : r * (q + 1) + (xcd - r) * q) + off; }
        const int nig = WGM * nN, gid = wgid / nig, fm = gid * WGM, gsz = (nM - fm) < WGM ? (nM - fm) : WGM;
        u.pm = fm + ((wgid % nig) % gsz); u.pn = (wgid % nig) / gsz; return true;
    }
};

template <class Epi>
__device__ __forceinline__ void gemm_phase(const int tid, PG8_LAS unsigned char* lds, const Gemm g, const StaticOrder& S, const Epi& E) {
    const int wid = __builtin_amdgcn_readfirstlane(tid >> 6), lane = tid & 63, wr = wid >> 2, wc = wid & 3, fr = lane & 15, fq = lane >> 4;
    const int K = g.K, nt = K / BK;
    unsigned voffA[2], voffB[2];
#pragma unroll
    for (int i = 0; i < 2; ++i) { int R, C; stage_rc(tid * 16 + i * 8192, R, C); const int Rb = Epi::PERM ? ((R & ~31) + perm32(R & 31)) : R;
        voffA[i] = (unsigned)(R * g.lda + C) * 2u; voffB[i] = (unsigned)(Rb * g.ldb + C) * 2u; }
    const size_t kstep = (size_t)(BK * 2);
    const size_t hstepA = (size_t)HALF * g.lda * 2, hstepB = (size_t)HALF * g.ldb * 2;
    const size_t tstepA = 2 * hstepA, tstepB = 2 * hstepB;
    const unsigned ldsw = (unsigned)wid * 1024u;
    const int aoff = lds_byte(wr * 64 + fr, fq * 8), boff = lds_byte(wc * 32 + fr, fq * 8);
#define PG8_SA(b, h) (((b) * 2 + (h)) * HTB)
#define PG8_SB(b, h) ((4 + (b) * 2 + (h)) * HTB)
#define PG8_STAGE(bufoff, gbase, voff) do { _Pragma("unroll") for (int _i = 0; _i < 2; ++_i) \
        __builtin_amdgcn_global_load_lds((const unsigned*)((const char*)(gbase) + (voff)[_i]), (PG8_LAS unsigned*)(lds + (bufoff) + ldsw + _i * 8192), 16, 0, 0); } while (0)
#define PG8_LDA(dst, b, h) do { _Pragma("unroll") for (int m = 0; m < 4; ++m) _Pragma("unroll") for (int k = 0; k < 2; ++k) dst[m][k] = *(const PG8_LAS bf16x8*)(lds + PG8_SA(b, h) + aoff + m * 2048 + k * 1024); } while (0)
#define PG8_LDB(dst, b, h) do { _Pragma("unroll") for (int n = 0; n < 2; ++n) _Pragma("unroll") for (int k = 0; k < 2; ++k) dst[n][k] = *(const PG8_LAS bf16x8*)(lds + PG8_SB(b, h) + boff + n * 2048 + k * 1024); } while (0)
#define PG8_MMA(ai, bj, At, Bt) do { __builtin_amdgcn_s_setprio(1); _Pragma("unroll") for (int m = 0; m < 4; ++m) _Pragma("unroll") for (int n = 0; n < 2; ++n) _Pragma("unroll") for (int k = 0; k < 2; ++k) \
        acc[ai][bj][m][n] = __builtin_amdgcn_mfma_f32_16x16x32_bf16(Bt[n][k], At[m][k], acc[ai][bj][m][n], 0, 0, 0); __builtin_amdgcn_s_setprio(0); } while (0)
#define PG8_WAIT_V(n) asm volatile("s_waitcnt vmcnt(" #n ")" ::: "memory")
#define PG8_WAIT_L(n) asm volatile("s_waitcnt lgkmcnt(" #n ")" ::: "memory")
#define PG8_BAR __builtin_amdgcn_s_barrier()
#define PG8_SCHED __builtin_amdgcn_sched_barrier(0)
#define PG8_ABASE(u) ((const char*)g.A + (size_t)(u).pm * tstepA + (g.agrp ? (size_t)((u).pn / g.agrp) * (size_t)K * 2 : (size_t)0))
#define PG8_BBASE(u) ((const char*)g.Bt + (size_t)(u).pn * tstepB + (g.bgrp ? (size_t)((u).pm / g.bgrp) * (size_t)K * 2 : (size_t)0))
    Unit cur, nxt; int ui = 0;
    if (!S.next(0, cur)) return;
    f32x4 acc[2][2][4][2];
#pragma unroll
    for (int a = 0; a < 2; ++a)
#pragma unroll
        for (int b = 0; b < 2; ++b)
#pragma unroll
            for (int m = 0; m < 4; ++m)
#pragma unroll
                for (int n = 0; n < 2; ++n) acc[a][b][m][n] = (f32x4){0.f, 0.f, 0.f, 0.f};
    bf16x8 At[4][2], B0[2][2], B1[2][2];
    const char* cA = PG8_ABASE(cur); const char* cB = PG8_BBASE(cur);
    PG8_STAGE(PG8_SB(0, 0), cB, voffB); PG8_STAGE(PG8_SA(0, 0), cA, voffA); PG8_STAGE(PG8_SB(0, 1), cB + hstepB, voffB); PG8_STAGE(PG8_SA(0, 1), cA + hstepA, voffA);
    if (wr == 1) PG8_BAR;
    PG8_WAIT_V(4); PG8_BAR;
    PG8_STAGE(PG8_SB(1, 0), cB + kstep, voffB); PG8_STAGE(PG8_SA(1, 0), cA + kstep, voffA); PG8_STAGE(PG8_SB(1, 1), cB + hstepB + kstep, voffB);
    PG8_WAIT_V(6); PG8_BAR;
    for (;;) {
        const bool has_next = S.next(ui + 1, nxt);
        const char* nA = has_next ? PG8_ABASE(nxt) : cA; const char* nB = has_next ? PG8_BBASE(nxt) : cB;
        for (int t = 0; t < nt; t += 2) {
            const bool last = (t == nt - 2);
            const char* a1 = cA + (size_t)(t + 1) * kstep;
            const char* a2 = last ? nA : cA + (size_t)(t + 2) * kstep; const char* b2 = last ? nB : cB + (size_t)(t + 2) * kstep;
            const char* a3 = a2 + kstep; const char* b3 = b2 + kstep;
            PG8_LDB(B0, 0, 0); PG8_SCHED; PG8_LDA(At, 0, 0); PG8_STAGE(PG8_SA(1, 1), a1 + hstepA, voffA);
            PG8_WAIT_L(8); PG8_BAR; PG8_WAIT_L(0); PG8_MMA(0, 0, At, B0); PG8_BAR; PG8_SCHED;
            PG8_LDB(B1, 0, 1); PG8_STAGE(PG8_SB(0, 0), b2, voffB);
            PG8_BAR; PG8_WAIT_L(0); PG8_MMA(0, 1, At, B1); PG8_BAR;
            PG8_LDA(At, 0, 1); PG8_STAGE(PG8_SA(0, 0), a2, voffA);
            PG8_BAR; PG8_WAIT_L(0); PG8_MMA(1, 0, At, B0); PG8_BAR; PG8_SCHED;
            PG8_STAGE(PG8_SB(0, 1), b2 + hstepB, voffB);
            PG8_WAIT_V(6); PG8_BAR; PG8_MMA(1, 1, At, B1); PG8_BAR;
            PG8_LDB(B0, 1, 0); PG8_SCHED; PG8_LDA(At, 1, 0); PG8_STAGE(PG8_SA(0, 1), a2 + hstepA, voffA);
            PG8_WAIT_L(8); PG8_BAR; PG8_WAIT_L(0); PG8_MMA(0, 0, At, B0); PG8_BAR; PG8_SCHED;
            PG8_LDB(B1, 1, 1); PG8_STAGE(PG8_SB(1, 0), b3, voffB);
            PG8_BAR; PG8_WAIT_L(0); PG8_MMA(0, 1, At, B1); PG8_BAR;
            PG8_LDA(At, 1, 1); PG8_STAGE(PG8_SA(1, 0), a3, voffA);
            PG8_BAR; PG8_WAIT_L(0); PG8_MMA(1, 0, At, B0); PG8_BAR; PG8_SCHED;
            PG8_STAGE(PG8_SB(1, 1), b3 + hstepB, voffB);
            PG8_WAIT_V(6); PG8_BAR; PG8_MMA(1, 1, At, B1); PG8_BAR;
        }
        E(acc, cur, wr, wc, fr, fq);
        if (!has_next) break;
#pragma unroll
        for (int a = 0; a < 2; ++a)
#pragma unroll
            for (int b = 0; b < 2; ++b)
#pragma unroll
                for (int m = 0; m < 4; ++m)
#pragma unroll
                    for (int n = 0; n < 2; ++n) acc[a][b][m][n] = (f32x4){0.f, 0.f, 0.f, 0.f};
        cur = nxt; cA = nA; cB = nB; ++ui;
    }
    PG8_WAIT_V(0);
    if (wr == 0) PG8_BAR;
    PG8_BAR;
#undef PG8_SA
#undef PG8_SB
#undef PG8_STAGE
#undef PG8_LDA
#undef PG8_LDB
#undef PG8_MMA
#undef PG8_WAIT_V
#undef PG8_WAIT_L
#undef PG8_BAR
#undef PG8_SCHED
#undef PG8_ABASE
#undef PG8_BBASE
}

struct EpiStore {
    static constexpr bool PERM = true;
    bf16_t* O; int ldc;
    __device__ __forceinline__ void operator()(const f32x4 (&acc)[2][2][4][2], const Unit& u, int wr, int wc, int fr, int fq) const {
        const int row0 = u.pm * BM + wr * 64 + fr, col0 = u.pn * BM + wc * 32 + 8 * fq;
#pragma unroll
        for (int ai = 0; ai < 2; ++ai)
#pragma unroll
            for (int m = 0; m < 4; ++m) { bf16_t* rowp = O + (size_t)(row0 + ai * HALF + m * 16) * ldc + col0;
#pragma unroll
                for (int bj = 0; bj < 2; ++bj) { const f32x4 v0 = acc[ai][bj][m][0], v1 = acc[ai][bj][m][1];
                    u32x4 w; w.x = cvt_pk_bf16(v0[0], v0[1]); w.y = cvt_pk_bf16(v0[2], v0[3]); w.z = cvt_pk_bf16(v1[0], v1[1]); w.w = cvt_pk_bf16(v1[2], v1[3]);
                    *(u32x4*)(rowp + bj * HALF) = w; } }
    }
};
struct EpiResid {
    static constexpr bool PERM = false;
    const float* base; float* out;
    __device__ __forceinline__ void operator()(const f32x4 (&acc)[2][2][4][2], const Unit& u, int wr, int wc, int fr, int fq) const {
        const int row0 = u.pm * BM + wr * 64 + fr, col0 = u.pn * BM + wc * 32 + 4 * fq;
        f32x4 bs[2][2][2][2];
#define ER_LOAD(Q, BUF) { _Pragma("unroll") for (int mm = 0; mm < 2; ++mm) { const size_t off = (size_t)(row0 + ((Q) >> 1) * HALF + (2 * ((Q) & 1) + mm) * 16) * 1024 + col0; \
            _Pragma("unroll") for (int bj = 0; bj < 2; ++bj) _Pragma("unroll") for (int n = 0; n < 2; ++n) bs[BUF][mm][bj][n] = *(const f32x4*)(base + off + bj * HALF + n * 16); } }
#define ER_STORE(Q, BUF) { _Pragma("unroll") for (int mm = 0; mm < 2; ++mm) { const size_t off = (size_t)(row0 + ((Q) >> 1) * HALF + (2 * ((Q) & 1) + mm) * 16) * 1024 + col0; \
            _Pragma("unroll") for (int bj = 0; bj < 2; ++bj) _Pragma("unroll") for (int n = 0; n < 2; ++n) *(f32x4*)(out + off + bj * HALF + n * 16) = bs[BUF][mm][bj][n] + acc[(Q) >> 1][bj][2 * ((Q) & 1) + mm][n]; } }
        ER_LOAD(0, 0) ER_LOAD(1, 1) ER_STORE(0, 0) ER_LOAD(2, 0) ER_STORE(1, 1) ER_LOAD(3, 1) ER_STORE(2, 0) ER_STORE(3, 1)
#undef ER_LOAD
#undef ER_STORE
    }
};
struct EpiRet {
    static constexpr bool PERM = true;
    bf16_t* O; const float* cosT; const float* sinT;
    __device__ __forceinline__ void operator()(const f32x4 (&acc)[2][2][4][2], const Unit& u, int wr, int wc, int fr, int fq) const {
        const int row0 = u.pm * BM + wr * 64 + fr, col0 = u.pn * BM + wc * 32 + 8 * fq;
        const bool rot = u.pn < 16; const float ksc = ((u.pn >> 2) & 1) ? 0.0625f : 1.0f;
        const int tcol = wc * 32 + 8 * fq;
        f32x4 cb[2][2], sb[2][2], cd[2], sd[2];
        if (rot) {
#pragma unroll
            for (int hh = 0; hh < 2; ++hh) { cd[hh] = *(const f32x4*)(cosT + 16 * 128 + tcol + 4 * hh); sd[hh] = *(const f32x4*)(sinT + 16 * 128 + tcol + 4 * hh);
#pragma unroll
                for (int ai = 0; ai < 2; ++ai) { const int ti = ((row0 + ai * HALF) & 4095) * 128 + tcol + 4 * hh; cb[ai][hh] = *(const f32x4*)(cosT + ti); sb[ai][hh] = *(const f32x4*)(sinT + ti); } }
        }
#pragma unroll
        for (int ai = 0; ai < 2; ++ai) {
            f32x4 c0 = cb[ai][0], c1 = cb[ai][1], s0 = sb[ai][0], s1 = sb[ai][1];
#pragma unroll
            for (int m = 0; m < 4; ++m) { const int row = row0 + ai * HALF + m * 16; bf16_t* rowp = O + (size_t)row * 8192 + col0;
                f32x4 a0 = acc[ai][0][m][0], a1 = acc[ai][0][m][1], b0 = acc[ai][1][m][0], b1 = acc[ai][1][m][1];
                if (rot) {
                    const f32x4 o0 = (a0 * c0 - b0 * s0) * ksc, o1 = (a1 * c1 - b1 * s1) * ksc, p0 = (b0 * c0 + a0 * s0) * ksc, p1 = (b1 * c1 + a1 * s1) * ksc;
                    a0 = o0; a1 = o1; b0 = p0; b1 = p1;
                    const f32x4 nc0 = c0 * cd[0] - s0 * sd[0], ns0 = s0 * cd[0] + c0 * sd[0], nc1 = c1 * cd[1] - s1 * sd[1], ns1 = s1 * cd[1] + c1 * sd[1];
                    c0 = nc0; s0 = ns0; c1 = nc1; s1 = ns1; }
                u32x4 w; w.x = cvt_pk_bf16(a0[0], a0[1]); w.y = cvt_pk_bf16(a0[2], a0[3]); w.z = cvt_pk_bf16(a1[0], a1[1]); w.w = cvt_pk_bf16(a1[2], a1[3]);
                *(u32x4*)(rowp) = w;
                w.x = cvt_pk_bf16(b0[0], b0[1]); w.y = cvt_pk_bf16(b0[2], b0[3]); w.z = cvt_pk_bf16(b1[0], b1[1]); w.w = cvt_pk_bf16(b1[2], b1[3]);
                *(u32x4*)(rowp + HALF) = w; }
        }
    }
};
}

template <class Epi>
__device__ __forceinline__ void run_gemm(const int tid, LAS unsigned char* lds, const bf16_t* A, int lda, const bf16_t* Bt, int ldb, int M, int N, int K, int agrp, const Epi& E, int bgrp = 0) {
    pg8::Gemm g; g.A = A; g.Bt = Bt; g.M = M; g.N = N; g.K = K; g.lda = lda; g.ldb = ldb; g.agrp = agrp; g.bgrp = bgrp;
    pg8::StaticOrder S; S.init(M, N, (int)gridDim.x, (int)blockIdx.x);
    pg8::gemm_phase<Epi>(tid, lds, g, S, E);
}

__device__ __forceinline__ void transpose_batch(const int tid, LAS unsigned char* lds, const float* src, bf16_t* dst, int K, int N, int batch, int src_ld = 0, size_t src_bs = 0, size_t dst_bs = 0) {
    LAS float* tile = (LAS float*)lds;
    if (src_ld == 0) src_ld = N; if (src_bs == 0) src_bs = (size_t)K * N; if (dst_bs == 0) dst_bs = (size_t)K * N;
    const int ntk = K / 64, ntn = N / 64, per = ntk * ntn, total = batch * per;
    for (int t = blockIdx.x; t < total; t += gridDim.x) {
        const int bt = t / per, rem = t - bt * per, tk = rem / ntn, tn = rem - tk * ntn;
        const float* s = src + (size_t)bt * src_bs + (size_t)(tk * 64) * src_ld + tn * 64;
        bf16_t* d = dst + (size_t)bt * dst_bs + (size_t)(tn * 64) * K + tk * 64;
#pragma unroll
        for (int i = 0; i < 8; ++i) { const int k = (tid >> 6) + 8 * i, n = tid & 63; tile[k * 65 + n] = s[(size_t)k * src_ld + n]; }
        __syncthreads();
#pragma unroll
        for (int i = 0; i < 8; ++i) { const int n = (tid >> 6) + 8 * i, k = tid & 63; const float v = tile[k * 65 + n]; d[(size_t)n * K + k] = (bf16_t)(cvt_pk_bf16(v, v) & 0xffffu); }
        __syncthreads();
    }
}
__device__ __forceinline__ void convert_rows(const int tid, const float* src, bf16_t* dst, int rows, int ncols, int src_ld) {
    const int per_row = ncols / 4, total = rows * per_row;
    for (int e = blockIdx.x * 512 + tid; e < total; e += gridDim.x * 512) { const int r = e / per_row, c4 = e - r * per_row;
        const f32x4 v = *(const f32x4*)(src + (size_t)r * src_ld + c4 * 4); u32x2 w; w.x = cvt_pk_bf16(v[0], v[1]); w.y = cvt_pk_bf16(v[2], v[3]); *(u32x2*)(dst + (size_t)r * ncols + c4 * 4) = w; }
}
__device__ __forceinline__ void sincos_d(double x, float& s, float& c) {
    const double q = rint(x * 0.63661977236758134308);
    const double r = (x - q * 1.57079632679489655800) - q * 6.12323399573676603587e-17;
    const double r2 = r * r;
    double sp = 1.0 / 6227020800.0; sp = sp * r2 - 1.0 / 39916800.0; sp = sp * r2 + 1.0 / 362880.0; sp = sp * r2 - 1.0 / 5040.0; sp = sp * r2 + 1.0 / 120.0; sp = sp * r2 - 1.0 / 6.0; sp = sp * r2 + 1.0; sp = sp * r;
    double cp = -1.0 / 87178291200.0; cp = cp * r2 + 1.0 / 479001600.0; cp = cp * r2 - 1.0 / 3628800.0; cp = cp * r2 + 1.0 / 40320.0; cp = cp * r2 - 1.0 / 720.0; cp = cp * r2 + 1.0 / 24.0; cp = cp * r2 - 0.5; cp = cp * r2 + 1.0;
    const int qi = ((int)q) & 3;
    const double ss = (qi == 0) ? sp : (qi == 1) ? cp : (qi == 2) ? -sp : -cp;
    const double cc = (qi == 0) ? cp : (qi == 1) ? -sp : (qi == 2) ? -cp : sp;
    s = (float)ss; c = (float)cc;
}
__device__ __forceinline__ void rope_tables(const int tid, float* rc, float* rs, float* ac, float* as) {
    const int gt = blockIdx.x * 512 + tid, gs = gridDim.x * 512;
    for (int e = gt; e < 4096 * 128; e += gs) { const int pos = e >> 7, i = e & 127;
        const float inv = (float)exp2(-13.287712379549449 * ((double)i / 128.0));
        const float ang = (float)pos * inv; float s, c; sincos_d((double)ang, s, c); rc[e] = c; rs[e] = s; }
    for (int e = gt; e < 4096 * 16; e += gs) { const int pos = e >> 4, i = e & 15;
        const float inv = (float)exp2(-18.931568569324174 * ((double)i / 16.0));
        const float ang = (float)pos * inv; float s, c; sincos_d((double)ang, s, c); ac[e] = c; as[e] = s; }
}

__device__ __forceinline__ void rmsnorm_phase(const int tid, const float* x, const float* w, bf16_t* h) {
    const int lane = tid & 63, gw = blockIdx.x * 8 + (tid >> 6), nw = gridDim.x * 8;
    f32x4 wv[4];
#pragma unroll
    for (int i = 0; i < 4; ++i) wv[i] = ((const f32x4*)w)[lane + 64 * i];
    if ((MH % (2 * nw)) != 0) return;
    for (int row = gw; row < MH; row += 2 * nw) {
        f32x4 v[2][4]; float ss[2];
#pragma unroll
        for (int r2 = 0; r2 < 2; ++r2) { const f32x4* xp = (const f32x4*)(x + (size_t)(row + r2 * nw) * 1024);
#pragma unroll
            for (int i = 0; i < 4; ++i) v[r2][i] = xp[lane + 64 * i]; }
#pragma unroll
        for (int r2 = 0; r2 < 2; ++r2) { float a = 0.f;
#pragma unroll
            for (int i = 0; i < 4; ++i) a += v[r2][i][0] * v[r2][i][0] + v[r2][i][1] * v[r2][i][1] + v[r2][i][2] * v[r2][i][2] + v[r2][i][3] * v[r2][i][3];
            ss[r2] = wave_sum(a); }
#pragma unroll
        for (int r2 = 0; r2 < 2; ++r2) { const float rstd = __builtin_amdgcn_rsqf(ss[r2] * (1.0f / 1024.0f) + EPS);
#pragma unroll
            for (int i = 0; i < 4; ++i) { const f32x4 o = v[r2][i] * rstd * wv[i]; u32x2 pk; pk.x = cvt_pk_bf16(o[0], o[1]); pk.y = cvt_pk_bf16(o[2], o[3]);
                *(u32x2*)(h + (size_t)(row + r2 * nw) * 1024 + 4 * (lane + 64 * i)) = pk; } }
    }
}

template <int H>
__device__ __forceinline__ void pool_mix_run(const bf16_t* ub, bf16_t* db, const float (&sc)[8], const int s0) {
    u32x4 ring[2 * H]; float sum[8];
#pragma unroll
    for (int e = 0; e < 8; ++e) sum[e] = 0.f;
#pragma unroll
    for (int k = 0; k < 2 * H; ++k) { const int rr = s0 - H + k; ring[k] = (u32x4){0u, 0u, 0u, 0u};
        if (rr >= 0 && rr < SEQ) ring[k] = *(const u32x4*)(ub + (size_t)rr * 4096);
        float v[8]; unpack8(ring[k], v);
#pragma unroll
        for (int e = 0; e < 8; ++e) sum[e] += v[e]; }
    for (int sb = s0; sb < s0 + 64; sb += 2 * H) {
#pragma unroll
        for (int t = 0; t < 2 * H; ++t) {
            const int s = sb + t;
            const int lo = (s - H) > 0 ? (s - H) : 0, hi = (s + H) < SEQ ? (s + H) : SEQ;
            const float inv = __builtin_amdgcn_rcpf((float)(hi - lo));
            const u32x4 gw = *(const u32x4*)(ub + (size_t)s * 4096 + 2048);
            u32x4 nw = (u32x4){0u, 0u, 0u, 0u}; if (s + H < SEQ) nw = *(const u32x4*)(ub + (size_t)(s + H) * 4096);
            float cv[8], gv[8], o[8], av[8], bv[8]; unpack8(ring[(t + H) % (2 * H)], cv); unpack8(gw, gv); unpack8(nw, av); unpack8(ring[t], bv);
#pragma unroll
            for (int e = 0; e < 8; ++e) { const float d = sum[e] * inv - cv[e]; o[e] = d * sc[e] * silu_f(gv[e]); }
            *(u32x4*)(db + (size_t)s * 2048) = pack8(o);
#pragma unroll
            for (int e = 0; e < 8; ++e) sum[e] += av[e] - bv[e];
            ring[t] = nw;
        }
    }
}
__device__ __forceinline__ void pool_mix_phase(const int tid, const bf16_t* mg, const float* scale, bf16_t* y) {
    const int total = HB * 64 * 256;
    for (int id = blockIdx.x * 512 + tid; id < total; id += gridDim.x * 512) {
        const int chunk = id & 255, run = (id >> 8) & 63, b = id >> 14;
        const int g = chunk >> 6;
        const bf16_t* ub = mg + (size_t)(b * SEQ) * 4096 + chunk * 8;
        bf16_t* db = y + (size_t)(b * SEQ) * 2048 + chunk * 8;
        const f32x4 sc0 = *(const f32x4*)(scale + chunk * 8), sc1 = *(const f32x4*)(scale + chunk * 8 + 4);
        const float sc[8] = {sc0[0], sc0[1], sc0[2], sc0[3], sc1[0], sc1[1], sc1[2], sc1[3]};
        const int s0 = run * 64;
        if (g == 0) pool_mix_run<1>(ub, db, sc, s0); else if (g == 1) pool_mix_run<2>(ub, db, sc, s0); else if (g == 2) pool_mix_run<4>(ub, db, sc, s0); else pool_mix_run<8>(ub, db, sc, s0);
    }
}

struct AttItem { int b, g, head, r, n0, dsh; };
__device__ __forceinline__ AttItem att_decode(int item) {
    AttItem it; const int pairidx = item & 31; it.head = (item >> 5) & 7; const int bg = item >> 8; it.g = bg % 3; it.b = bg / 3;
    it.dsh = 2 * it.g; const int ppr = 32 >> it.dsh; it.r = pairidx / ppr; it.n0 = 2 * (pairidx - it.r * ppr); return it;
}
__device__ __forceinline__ void att_load_half(const AttItem& it, const int tid, const bf16_t* proj, const float* cosT, const float* sinT, const int I0,
                                              u32x4 (&kvs)[4], u32x4 (&vvs)[4], f32x4 (&kct)[2], f32x4 (&kst)[2]) {
    const int ch = tid & 15, rowb = tid >> 4, dil = 1 << it.dsh, nsub = 4096 >> it.dsh;
    const bf16_t* base = proj + (size_t)(it.b * SEQ) * 10240 + it.g * 3072 + it.head * 128;
#pragma unroll
    for (int i4 = 0; i4 < 4; ++i4) {
        const int jk = (it.n0 - 1) * 64 + rowb + 32 * (I0 + i4); const bool valid = (jk >= 0) && (jk < nsub);
        kvs[i4] = (u32x4){0u, 0u, 0u, 0u}; vvs[i4] = (u32x4){0u, 0u, 0u, 0u};
        if (valid) { const bf16_t* p = base + (size_t)(jk * dil + it.r) * 10240; kvs[i4] = *(const u32x4*)(p + 1024 + ch * 8); vvs[i4] = *(const u32x4*)(p + 2048 + ch * 8); }
    }
    const int pb = ((it.n0 - 1) * 64 + rowb + 32 * I0) * dil + it.r, pa = pb < 0 ? -pb : pb;
#pragma unroll
    for (int hh = 0; hh < 2; ++hh) { kct[hh] = *(const f32x4*)(cosT + pa * 16 + (ch & 1) * 8 + 4 * hh); kst[hh] = *(const f32x4*)(sinT + pa * 16 + (ch & 1) * 8 + 4 * hh); }
}
__device__ __forceinline__ void att_load_q(const AttItem& it, const int tid, const bf16_t* proj, u32x4 (&qraw)[4]) {
    const int dil = 1 << it.dsh, lane = tid & 63, fr = lane & 15, fq = lane >> 4, ql = (tid >> 6) * 16 + fr, posq = (it.n0 * 64 + ql) * dil + it.r;
    const bf16_t* qp = proj + (size_t)(it.b * SEQ) * 10240 + it.g * 3072 + it.head * 128 + (size_t)posq * 10240;
#pragma unroll
    for (int s = 0; s < 4; ++s) qraw[s] = *(const u32x4*)(qp + 32 * s + 8 * fq);
}

__device__ __forceinline__ void attn_phase(const int tid_in, LAS unsigned char* lds, bf16_t* proj, float* lse, const float* qn, const float* kn, const float* cosT, const float* sinT) {
    LAS unsigned char* Kimg = lds; LAS unsigned char* Vimg = lds + 65536;
    const int nitems = HB * 3 * 8 * 32;
    LAS float* gq = (LAS float*)(lds + 131072); LAS float* gk = gq + 384; LAS float* dtab = gk + 384;
    if (tid_in < 384) { gq[tid_in] = qn[tid_in]; gk[tid_in] = kn[tid_in]; }
    if (tid_in < 96) { const int gg = tid_in >> 5, i = tid_in & 31; dtab[tid_in] = (i < 16) ? cosT[(32 << (2 * gg)) * 16 + i] : sinT[(32 << (2 * gg)) * 16 + (i - 16)]; }
    __syncthreads();
    const int tid = tid_in, w = tid >> 6, lane = tid & 63, fr = lane & 15, fq = lane >> 4;
    LAS const unsigned char* kbase[2][4]; LAS const unsigned char* vb2[2]; unsigned xe2[2];
#pragma unroll
    for (int h = 0; h < 2; ++h)
#pragma unroll
        for (int s = 0; s < 4; ++s) kbase[h][s] = Kimg + off_b(8 * (fr >> 2) + 4 * h + (fr & 3), 4 * s + fq);
#pragma unroll
    for (int t = 0; t < 2; ++t) { const unsigned q = (lane & 15) >> 2, p = lane & 3, Xt = (q << 2) | ((2 * fq + t) & 3);
        vb2[t] = Vimg + 256 * (8 * fq + 4 * t + q) + 16 * ((p >> 1) ^ (Xt & 1)) + 8 * (p & 1); xe2[t] = Xt >> 1; }
    const int per_blk = (nitems + (int)gridDim.x - 1) / (int)gridDim.x, item_lo = (int)blockIdx.x * per_blk, item_hi = (item_lo + per_blk) < nitems ? (item_lo + per_blk) : nitems;
    for (int item = item_lo; item < item_hi; ++item) {
        const AttItem it = att_decode(item);
        const int head = it.head, g = it.g, b = it.b, r = it.r, n0 = it.n0, dsh = it.dsh, dil = 1 << dsh, nsub = 4096 >> dsh;
        const bool cont = (item > item_lo) && (n0 != 0);
        u32x4 kvs[4], vvs[4], qraw[4]; f32x4 kct[2], kst[2];
        att_load_q(it, tid, proj, qraw);
        att_load_half(it, tid, proj, cosT, sinT, 4, kvs, vvs, kct, kst);
        const int p0 = __builtin_amdgcn_readfirstlane((n0 - 1 + (w >> 2)) & 3);
        const int offj[3] = {16384 * p0, 16384 * ((p0 + 1) & 3), 16384 * ((p0 + 2) & 3)};
        bf16_t* base = proj + (size_t)(b * SEQ) * 10240 + g * 3072 + head * 128;
        const int ch = tid & 15, rowb = tid >> 4;
        const int ql = w * 16 + fr, jq = n0 * 64 + ql, posq = jq * dil + r;
        bf16_t* qp = base + (size_t)posq * 10240;
        const int pbase = ((n0 - 1) * 64 + rowb) * dil + r, pabs = pbase < 0 ? -pbase : pbase;
        f32x4 wkv[2], kcd[2], ksd[2], qc[2], qs[2];
#pragma unroll
        for (int hh = 0; hh < 2; ++hh) {
            qc[hh] = *(const f32x4*)(cosT + posq * 16 + (fq & 1) * 8 + 4 * hh); qs[hh] = *(const f32x4*)(sinT + posq * 16 + (fq & 1) * 8 + 4 * hh);
            wkv[hh] = *(const LAS f32x4*)(gk + g * 128 + ch * 8 + 4 * hh);
            kcd[hh] = *(const LAS f32x4*)(dtab + g * 32 + (ch & 1) * 8 + 4 * hh); ksd[hh] = *(const LAS f32x4*)(dtab + g * 32 + 16 + (ch & 1) * 8 + 4 * hh);
        }
        bf16x8 qfrag[4];
        {
            float qf[4][8]; float ss = 0.f;
#pragma unroll
            for (int s = 0; s < 4; ++s) { unpack8(qraw[s], qf[s]);
#pragma unroll
                for (int e = 0; e < 8; ++e) ss += qf[s][e] * qf[s][e]; }
            ss = xrow16_sum(ss);
            const float rstd = __builtin_amdgcn_rsqf(ss * (1.0f / 128.0f) + EPS);
#pragma unroll
            for (int s = 0; s < 4; ++s)
#pragma unroll
                for (int e = 0; e < 8; ++e) qf[s][e] = qf[s][e] * rstd * gq[g * 128 + 32 * s + 8 * fq + e];
#pragma unroll
            for (int e = 0; e < 8; ++e) { const float pr = lane_xor32(qf[0][e], fq < 2); const float c = qc[e >> 2][e & 3], sn = qs[e >> 2][e & 3];
                qf[0][e] = (fq < 2) ? (qf[0][e] * c - pr * sn) : (qf[0][e] * c + pr * sn); }
            const float sc = 0.08838834764831845f * 1.4426950408889634f;
#pragma unroll
            for (int s = 0; s < 4; ++s) {
#pragma unroll
                for (int e = 0; e < 8; ++e) qf[s][e] *= sc;
                qfrag[s] = __builtin_bit_cast(bf16x8, pack8(qf[s])); }
        }
#define ATT_STAGE_HALF(I0, CC0, SS0, NEG) { float cc[8], sn[8]; \
            _Pragma("unroll") for (int e = 0; e < 8; ++e) { cc[e] = CC0[e >> 2][e & 3]; sn[e] = (NEG) ? -SS0[e >> 2][e & 3] : SS0[e >> 2][e & 3]; } \
            _Pragma("unroll") for (int i = (I0); i < (I0) + 4; ++i) { \
                if ((i & 1) == 0) __builtin_amdgcn_sched_barrier(0); \
                const int slot = (n0 - 1 + (i >> 1)) & 3; \
                float x[8]; unpack8(kvs[i - (I0)], x); \
                float ss = 0.f; \
                _Pragma("unroll") for (int e = 0; e < 8; ++e) ss += x[e] * x[e]; \
                ss = row16_sum(ss); \
                const float rstd = __builtin_amdgcn_rsqf(ss * (1.0f / 128.0f) + EPS); \
                _Pragma("unroll") for (int e = 0; e < 8; ++e) x[e] = x[e] * rstd * wkv[e >> 2][e & 3]; \
                _Pragma("unroll") for (int e = 0; e < 8; ++e) { const float pr = dpp_f<0x4E>(x[e]); const float rot = (ch < 2) ? (x[e] * cc[e] - pr * sn[e]) : (x[e] * cc[e] + pr * sn[e]); x[e] = (ch < 4) ? rot : x[e]; } \
                *(LAS u32x4*)(Kimg + 16384 * slot + off_b(rowb + 32 * (i & 1), ch)) = pack8(x); \
                *(LAS u32x4*)(Vimg + 16384 * slot + off_b(rowb + 32 * (i & 1), ch)) = vvs[i - (I0)]; \
                _Pragma("unroll") for (int e = 0; e < 8; ++e) { const float cd = kcd[e >> 2][e & 3], sd = ksd[e >> 2][e & 3]; const float c2 = cc[e] * cd - sn[e] * sd, s2 = sn[e] * cd + cc[e] * sd; cc[e] = c2; sn[e] = s2; } } }
        ATT_STAGE_HALF(4, kct, kst, false)
        if (!cont) { att_load_half(it, tid, proj, cosT, sinT, 0, kvs, vvs, kct, kst); ATT_STAGE_HALF(0, kct, kst, pbase < 0) }
#undef ATT_STAGE_HALF
        __syncthreads();
        const int mskip = __builtin_amdgcn_readfirstlane(((w & 3) < 2) ? 5 : 0);
        f32x4 sacc[12];
#pragma unroll
        for (int tt = 0; tt < 12; ++tt) {
            if ((tt & 1) == 0) __builtin_amdgcn_sched_barrier(0);
            sacc[tt] = (f32x4){0.f, 0.f, 0.f, 0.f};
            if ((tt >> 1) != mskip)
#pragma unroll
            for (int s = 0; s < 4; ++s) { const bf16x8 kf = *(const LAS bf16x8*)(kbase[tt & 1][s] + offj[tt >> 2] + 8192 * ((tt >> 1) & 1)); sacc[tt] = mfma16(kf, qfrag[s], sacc[tt]); }
        }
        const int jkb = (n0 - 1) * 64 + (w >> 2) * 64, qlw = (w & 3) * 16 + fr;
        const int lo2 = (qlw > -jkb ? qlw : -jkb) - 8 * fq, hi2 = ((qlw + 128) < (nsub - 1 - jkb) ? (qlw + 128) : (nsub - 1 - jkb)) - 8 * fq;
        float mx = -3.0e38f;
#pragma unroll
        for (int tt = 0; tt < 12; ++tt)
#pragma unroll
            for (int j = 0; j < 4; ++j) { const int kc = 32 * (tt >> 1) + 4 * (tt & 1) + j;
                const bool ok = (kc >= lo2) && (kc <= hi2);
                const float v = ok ? sacc[tt][j] : -1.0e30f; sacc[tt][j] = v; mx = fmaxf(mx, v); }
        mx = xrow16_max(mx);
        float sum = 0.f;
#pragma unroll
        for (int tt = 0; tt < 12; ++tt)
#pragma unroll
            for (int j = 0; j < 4; ++j) { const float p = __builtin_amdgcn_exp2f(sacc[tt][j] - mx); sacc[tt][j] = p; sum += p; }
        sum = xrow16_sum(sum);
        bf16x8 pfrag[6];
#pragma unroll
        for (int m = 0; m < 6; ++m) { u32x4 pw; pw.x = cvt_pk_bf16(sacc[2 * m][0], sacc[2 * m][1]); pw.y = cvt_pk_bf16(sacc[2 * m][2], sacc[2 * m][3]);
            pw.z = cvt_pk_bf16(sacc[2 * m + 1][0], sacc[2 * m + 1][1]); pw.w = cvt_pk_bf16(sacc[2 * m + 1][2], sacc[2 * m + 1][3]); pfrag[m] = __builtin_bit_cast(bf16x8, pw); }
        f32x4 oacc[8];
#pragma unroll
        for (int c = 0; c < 8; ++c) oacc[c] = (f32x4){0.f, 0.f, 0.f, 0.f};
#pragma unroll
        for (int ks = 0; ks < 6; ++ks)
            if (ks != mskip)
#pragma unroll
            for (int c = 0; c < 8; ++c) {
                if ((c & 3) == 0) __builtin_amdgcn_sched_barrier(0);
                const s16x4 lo = __builtin_amdgcn_ds_read_tr16_b64_v4i16((LAS s16x4*)(vb2[0] + 32 * (c ^ xe2[0]) + offj[ks >> 1] + 8192 * (ks & 1))), hi = __builtin_amdgcn_ds_read_tr16_b64_v4i16((LAS s16x4*)(vb2[1] + 32 * (c ^ xe2[1]) + offj[ks >> 1] + 8192 * (ks & 1)));
                bf16x8 vf; vf[0] = lo[0]; vf[1] = lo[1]; vf[2] = lo[2]; vf[3] = lo[3]; vf[4] = hi[0]; vf[5] = hi[1]; vf[6] = hi[2]; vf[7] = hi[3];
                oacc[c] = mfma16(vf, pfrag[ks], oacc[c]); }
        const float inv = __builtin_amdgcn_rcpf(sum);
#pragma unroll
        for (int c = 0; c < 8; ++c) { const f32x4 o = oacc[c] * inv; u32x2 pw; pw.x = cvt_pk_bf16(o[0], o[1]); pw.y = cvt_pk_bf16(o[2], o[3]); *(u32x2*)(qp + 16 * c + 4 * fq) = pw; }
        if (fq == 0) lse[(size_t)(b * SEQ + posq) * 24 + g * 8 + head] = (mx + log2f(sum)) * 0.6931471805599453f;
        __syncthreads();
    }
}

__device__ __forceinline__ void attn_combine_phase(const int tid, bf16_t* proj, const float* lse) {
    const int lane = tid & 63, gw = blockIdx.x * 8 + (tid >> 6), nw = gridDim.x * 8;
    if (((MH * 2) % (2 * nw)) != 0) return;
    for (int task0 = gw; task0 < MH * 2; task0 += 2 * nw) {
        u32x4 ra[2], rb[2], rc[2], rg[2]; float l0[2], l1[2], l2[2];
#pragma unroll
        for (int t2 = 0; t2 < 2; ++t2) { const int task = task0 + t2 * nw, row = task >> 1, head = (task & 1) * 4 + (lane >> 4), d0 = (lane & 15) * 8;
            const bf16_t* p = proj + (size_t)row * 10240 + head * 128 + d0; const float* lp = lse + (size_t)row * 24 + head;
            ra[t2] = *(const u32x4*)(p); rb[t2] = *(const u32x4*)(p + 3072); rc[t2] = *(const u32x4*)(p + 6144); rg[t2] = *(const u32x4*)(proj + (size_t)row * 10240 + 9216 + head * 128 + d0);
            l0[t2] = lp[0]; l1[t2] = lp[8]; l2[t2] = lp[16]; }
#pragma unroll
        for (int t2 = 0; t2 < 2; ++t2) { const int task = task0 + t2 * nw, row = task >> 1, head = (task & 1) * 4 + (lane >> 4), d0 = (lane & 15) * 8;
            const float m = fmaxf(l0[t2], fmaxf(l1[t2], l2[t2]));
            float w0 = __expf(l0[t2] - m), w1 = __expf(l1[t2] - m), w2 = __expf(l2[t2] - m);
            const float inv = __builtin_amdgcn_rcpf(w0 + w1 + w2); w0 *= inv; w1 *= inv; w2 *= inv;
            float a[8], bq[8], c[8], gt[8], o[8];
            unpack8(ra[t2], a); unpack8(rb[t2], bq); unpack8(rc[t2], c); unpack8(rg[t2], gt);
#pragma unroll
            for (int e = 0; e < 8; ++e) { const float y = w0 * a[e] + w1 * bq[e] + w2 * c[e]; o[e] = y * silu_f(gt[e]); }
            *(u32x4*)(proj + (size_t)row * 10240 + head * 128 + d0) = pack8(o); }
    }
}

__device__ __forceinline__ void ret_chain_phase(int tid, LAS unsigned char* lds, const bf16_t* proj, bf16_t* outbuf, const float* decay) {
    const int w = tid >> 6, lane = tid & 63, fr = lane & 15, fq = lane >> 4;
    LAS unsigned char* R1 = lds; LAS unsigned char* RV = lds + 65536;
    for (int item = blockIdx.x; item < HB * 32; item += gridDim.x) {
        const int vs = item & 3, dir = (item >> 2) & 1, h = (item >> 3) & 3, b = item >> 5;
        asm volatile("" : "+v"(tid)); const int ti = tid;
        const int w = ti >> 6, fr = ti & 15, fq = (ti & 63) >> 4;
        const float lg2 = log2f(1.0f - exp2f(-decay[dir * 4 + h]));
        const float gC = exp2f(128.0f * lg2);
        const int ql = w * 16 + fr;
        const float qd = exp2f(lg2 * (float)(dir ? (128 - ql) : (ql + 1)));
        const float rs = exp2f(lg2 * (float)(dir ? (-ql) : (ql - 127)));
        const float kd0 = exp2f(lg2 * (float)(dir ? (ti >> 5) : (127 - (ti >> 5)))), kdstep = exp2f(lg2 * (dir ? 16.0f : -16.0f));
        const int qlo = dir ? (ql + 1) : 0, qhi = dir ? 127 : ql;
        const int lo2 = qlo - 8 * fq, hi2 = qhi - 8 * fq;
        f32x4 st[2][8];
#pragma unroll
        for (int rt = 0; rt < 2; ++rt)
#pragma unroll
            for (int c = 0; c < 8; ++c) st[rt][c] = (f32x4){0.f, 0.f, 0.f, 0.f};
        const int qcol = (dir ? 2048 : 0) + h * 256, kcol = (dir ? 3072 : 1024) + h * 256, vcol = 4096 + h * 512 + vs * 128;
        bf16x8 qfrag[8];
        { const bf16_t* qp0 = proj + (size_t)(b * SEQ + (dir ? 31 : 0) * 128 + ql) * 8192 + qcol;
#pragma unroll
            for (int s = 0; s < 8; ++s) qfrag[s] = *(const bf16x8*)(qp0 + 32 * s + 8 * fq); }
        for (int step = 0; step < 32; ++step) {
            const int cidx = dir ? (31 - step) : step, row0 = b * SEQ + cidx * 128;
            asm volatile("" : "+v"(tid)); const int tz = tid;
            const int zw = tz >> 6, zl = tz & 63, zfr = zl & 15, zfq = zl >> 4;
            const int w = zw, fr = zfr, fq = zfq, ql = zw * 16 + zfr; const unsigned xs = zfr & 3;
            LAS const unsigned char* sb1 = R1 + off_b(zfr, zfq ^ (4 * xs));
            LAS const unsigned char* kb1[2]; LAS const unsigned char* vb2[2]; unsigned xe2[2];
#pragma unroll
            for (int hh = 0; hh < 2; ++hh) kb1[hh] = R1 + off_b(8 * (zfr >> 2) + 4 * hh + (zfr & 3), zfq ^ (4 * xs));
#pragma unroll
            for (int t = 0; t < 2; ++t) { const unsigned q = (unsigned)zfr >> 2, pp = zfr & 3, Xt = (q << 2) | ((2 * zfq + t) & 3);
                vb2[t] = RV + 256 * (8 * zfq + 4 * t + q) + 16 * ((pp >> 1) ^ (Xt & 1)) + 8 * (pp & 1); xe2[t] = Xt >> 1; }
            LAS const unsigned char* ktb[2][2]; LAS unsigned char* swb[2];
#pragma unroll
            for (int rt = 0; rt < 2; ++rt) { swb[rt] = R1 + (zw >> 2) * 32768 + off_b(zfr, 4 * (zw & 3) + 2 * rt + (zfq >> 1)) + 8 * (zfq & 1);
#pragma unroll
                for (int t = 0; t < 2; ++t) ktb[rt][t] = R1 + (zw >> 2) * 32768 + tr_addr16(zl, 2 * (zw & 3) + rt, 0, t); }
            LAS unsigned char* kwb = R1 + ((tz & 31) >> 4) * 32768 + off_b(tz >> 5, tz & 15);
            LAS unsigned char* vwb = RV + off_b(tz >> 4, tz & 15);
            u32x4 kraw[8], vraw[4];
            const bf16_t* kg = proj + (size_t)(row0 + (tz >> 5)) * 8192 + kcol + (tz & 31) * 8;
            const bf16_t* vg = proj + (size_t)(row0 + (tz >> 4)) * 8192 + vcol + (tz & 15) * 8;
#pragma unroll
            for (int i = 0; i < 4; ++i) kraw[i] = *(const u32x4*)(kg + (size_t)i * 16 * 8192);
            f32x4 oacc[8];
#pragma unroll
            for (int c = 0; c < 8; ++c) oacc[c] = (f32x4){0.f, 0.f, 0.f, 0.f};
            if (step > 0) {
                bf16x8 fbuf[2][4];
#define QS_LOAD(G, BUF) { _Pragma("unroll") for (int j = 0; j < 4; ++j) { const int n = 4 * (G) + j, c = n >> 3, s = n & 7; fbuf[BUF][j] = *(const LAS bf16x8*)(sb1 + 64 * ((s & 3) ^ xs) + 4096 * c + 32768 * (s >> 2)); } }
                QS_LOAD(0, 0)
#pragma unroll
                for (int g = 0; g < 16; ++g) {
                    if (g + 1 < 16) QS_LOAD(g + 1, (g + 1) & 1)
                    __builtin_amdgcn_sched_barrier(0);
                    __builtin_amdgcn_s_setprio(1);
#pragma unroll
                    for (int j = 0; j < 4; ++j) { const int n = 4 * g + j, c = n >> 3, s = n & 7; oacc[c] = mfma16(fbuf[g & 1][j], qfrag[s], oacc[c]); }
                    __builtin_amdgcn_s_setprio(0);
                    __builtin_amdgcn_sched_barrier(0);
                }
#undef QS_LOAD
#pragma unroll
                for (int c = 0; c < 8; ++c) oacc[c] = oacc[c] * qd;
            }
#pragma unroll
            for (int i = 4; i < 8; ++i) kraw[i] = *(const u32x4*)(kg + (size_t)i * 16 * 8192);
            __syncthreads();
#pragma unroll
            for (int i = 0; i < 4; ++i) vraw[i] = *(const u32x4*)(vg + (size_t)i * 32 * 8192);
            { float kd = kd0;
#pragma unroll
              for (int i = 0; i < 8; ++i) {
                float x[8]; unpack8(kraw[i], x);
#pragma unroll
                for (int e = 0; e < 8; ++e) x[e] *= kd;
                *(LAS u32x4*)(kwb + 4096 * i) = pack8(x); kd *= kdstep; } }
#pragma unroll
            for (int i = 0; i < 4; ++i) *(LAS u32x4*)(vwb + 8192 * i) = vraw[i];
            __syncthreads();
            f32x4 sacc[8];
#pragma unroll
            for (int tt = 0; tt < 8; ++tt) sacc[tt] = (f32x4){0.f, 0.f, 0.f, 0.f};
            {
                bf16x8 fbuf[2][4];
#define ST_LOAD(G, BUF) { _Pragma("unroll") for (int j = 0; j < 4; ++j) { const int n = 4 * (G) + j, tt = n >> 3, s = n & 7; fbuf[BUF][j] = *(const LAS bf16x8*)(kb1[tt & 1] + 64 * ((s & 3) ^ xs) + 8192 * (tt >> 1) + 32768 * (s >> 2)); } }
                ST_LOAD(0, 0)
#pragma unroll
                for (int g = 0; g < 16; ++g) {
                    if (g + 1 < 16) ST_LOAD(g + 1, (g + 1) & 1)
                    __builtin_amdgcn_sched_barrier(0);
                    __builtin_amdgcn_s_setprio(1);
#pragma unroll
                    for (int j = 0; j < 4; ++j) { const int n = 4 * g + j, tt = n >> 3, s = n & 7; sacc[tt] = mfma16(fbuf[g & 1][j], qfrag[s], sacc[tt]); }
                    __builtin_amdgcn_s_setprio(0);
                    __builtin_amdgcn_sched_barrier(0);
                }
#undef ST_LOAD
            }
            bf16x8 pfrag[4];
#pragma unroll
            for (int m = 0; m < 4; ++m) { float pv[8];
#pragma unroll
                for (int i = 0; i < 8; ++i) { const int kc = 32 * m + i; const bool keep = (kc >= lo2) && (kc <= hi2);
                    pv[i] = keep ? sacc[2 * m + (i >> 2)][i & 3] * rs : 0.f; }
                pfrag[m] = __builtin_bit_cast(bf16x8, pack8(pv)); }
#pragma unroll
            for (int rt = 0; rt < 2; ++rt)
#pragma unroll
                for (int c = 0; c < 8; ++c) st[rt][c] = st[rt][c] * gC;
            if (step < 31) { const int ncidx = dir ? (30 - step) : (step + 1); const bf16_t* qpn = proj + (size_t)(b * SEQ + ncidx * 128 + (tz >> 6) * 16 + ((tz & 63) & 15)) * 8192 + qcol + 8 * ((tz & 63) >> 4);
#pragma unroll
                for (int s = 0; s < 8; ++s) qfrag[s] = *(const bf16x8*)(qpn + 32 * s); }
            {
                bf16x8 vfb[2][2], ktq[2][2];
#define TR8(PTR_LO, PTR_HI, DST) { const s16x4 lo_ = __builtin_amdgcn_ds_read_tr16_b64_v4i16((LAS s16x4*)(PTR_LO)), hi_ = __builtin_amdgcn_ds_read_tr16_b64_v4i16((LAS s16x4*)(PTR_HI)); \
        DST[0] = lo_[0]; DST[1] = lo_[1]; DST[2] = lo_[2]; DST[3] = lo_[3]; DST[4] = hi_[0]; DST[5] = hi_[1]; DST[6] = hi_[2]; DST[7] = hi_[3]; }
#define VF_LOAD(G, BUF) { _Pragma("unroll") for (int j = 0; j < 2; ++j) { const int ks = (G) >> 2, c = 2 * ((G) & 3) + j; TR8(vb2[0] + 32 * (c ^ xe2[0]) + 8192 * ks, vb2[1] + 32 * (c ^ xe2[1]) + 8192 * ks, vfb[BUF][j]) } }
#define KT_LOAD(KS, BUF) { _Pragma("unroll") for (int rt = 0; rt < 2; ++rt) TR8(ktb[rt][0] + 8192 * (KS), ktb[rt][1] + 8192 * (KS), ktq[BUF][rt]) }
                KT_LOAD(0, 0) VF_LOAD(0, 0)
#pragma unroll
                for (int g = 0; g < 16; ++g) {
                    if (g + 1 < 16) VF_LOAD(g + 1, (g + 1) & 1)
                    if ((g & 3) == 3 && g + 1 < 16) KT_LOAD((g + 1) >> 2, ((g + 1) >> 2) & 1)
                    __builtin_amdgcn_sched_barrier(0);
#pragma unroll
                    for (int j = 0; j < 2; ++j) { const int ks = g >> 2, c = 2 * (g & 3) + j;
                        oacc[c] = mfma16(vfb[g & 1][j], pfrag[ks], oacc[c]); st[0][c] = mfma16(ktq[ks & 1][0], vfb[g & 1][j], st[0][c]); st[1][c] = mfma16(ktq[ks & 1][1], vfb[g & 1][j], st[1][c]); }
                    __builtin_amdgcn_sched_barrier(0);
                }
#undef VF_LOAD
#undef KT_LOAD
#undef TR8
            }
            { bf16_t* op = outbuf + (size_t)dir * MH * 2048 + (size_t)(row0 + ql) * 2048 + h * 512 + vs * 128;
#pragma unroll
                for (int c = 0; c < 8; ++c) { u32x2 pw; pw.x = cvt_pk_bf16(oacc[c][0], oacc[c][1]); pw.y = cvt_pk_bf16(oacc[c][2], oacc[c][3]); *(u32x2*)(op + 16 * c + 4 * fq) = pw; } }
            __syncthreads();
#pragma unroll
            for (int rt = 0; rt < 2; ++rt)
#pragma unroll
                for (int c = 0; c < 8; ++c) { u32x2 pw; pw.x = cvt_pk_bf16(st[rt][c][0], st[rt][c][1]); pw.y = cvt_pk_bf16(st[rt][c][2], st[rt][c][3]);
                    *(LAS u32x2*)(swb[rt] + 4096 * c) = pw; }
            __syncthreads();
        }
    }
}

__device__ __forceinline__ void ret_combine_phase(const int tid, bf16_t* proj, const bf16_t* outbuf) {
    const int lane = tid & 63, gw = blockIdx.x * 8 + (tid >> 6), nw = gridDim.x * 8;
    if (((MH * 4) % (2 * nw)) != 0) return;
    for (int task0 = gw; task0 < MH * 4; task0 += 2 * nw) {
        u32x4 ra[2], rb[2], rg[2];
#pragma unroll
        for (int t2 = 0; t2 < 2; ++t2) { const int task = task0 + t2 * nw, row = task >> 2, h = task & 3, col = h * 512 + lane * 8;
            ra[t2] = *(const u32x4*)(outbuf + (size_t)row * 2048 + col); rb[t2] = *(const u32x4*)(outbuf + (size_t)MH * 2048 + (size_t)row * 2048 + col);
            rg[t2] = *(const u32x4*)(proj + (size_t)row * 8192 + 6144 + col); }
#pragma unroll
        for (int t2 = 0; t2 < 2; ++t2) { const int task = task0 + t2 * nw, row = task >> 2, h = task & 3, col = h * 512 + lane * 8;
            float a[8], bq[8], gt[8], o[8]; unpack8(ra[t2], a); unpack8(rb[t2], bq); unpack8(rg[t2], gt);
            float ss = 0.f;
#pragma unroll
            for (int e = 0; e < 8; ++e) { a[e] += bq[e]; ss += a[e] * a[e]; }
            ss = wave_sum(ss);
            const float rstd = __builtin_amdgcn_rsqf(ss * (1.0f / 512.0f) + EPS);
#pragma unroll
            for (int e = 0; e < 8; ++e) o[e] = a[e] * rstd * silu_f(gt[e]);
            *(u32x4*)(proj + (size_t)row * 8192 + col) = pack8(o); }
    }
}

__device__ __forceinline__ void grid_barrier(unsigned* ctr, unsigned target) {
    asm volatile("s_waitcnt vmcnt(0) lgkmcnt(0)" ::: "memory");
    __syncthreads();
    if (threadIdx.x < 64) {
        asm volatile("buffer_wbl2 sc1\n\ts_waitcnt vmcnt(0)" ::: "memory");
        if (threadIdx.x == 0) {
            __hip_atomic_fetch_add(ctr, 1u, __ATOMIC_RELAXED, __HIP_MEMORY_SCOPE_AGENT);
            while (__hip_atomic_load(ctr, __ATOMIC_RELAXED, __HIP_MEMORY_SCOPE_AGENT) < target) __builtin_amdgcn_s_sleep(2);
        }
        asm volatile("buffer_inv sc1\n\ts_waitcnt vmcnt(0)" ::: "memory");
    }
    __syncthreads();
}

#define PH_N 28
static __device__ const unsigned char PH_TAB[PH_N] = {1, 2, 4, 9, 10, 12, 17, 18, 19, 20, 25, 26, 27, 28, 33, 34, 35, 36, 41, 42, 43, 44, 49, 50, 52, 57, 58, 60};

__global__ void __launch_bounds__(512, 2) mega_fwd(Params p) {
    extern __shared__ __attribute__((aligned(16))) unsigned char smem[];
    LAS unsigned char* lds = (LAS unsigned char*)smem;
    cg::grid_group grid = cg::this_grid();
    unsigned char* ws = p.ws;
    bf16_t* wt_pool_in = (bf16_t*)(ws + WS_WT_POOL_IN); bf16_t* wt_pool_g = (bf16_t*)(ws + WS_WT_POOL_G); bf16_t* wt_pool_out = (bf16_t*)(ws + WS_WT_POOL_OUT);
    bf16_t* wt_att_in = (bf16_t*)(ws + WS_WT_ATT_IN); bf16_t* wt_att_out = (bf16_t*)(ws + WS_WT_ATT_OUT);
    bf16_t* wt_ret_in = (bf16_t*)(ws + WS_WT_RET_IN); bf16_t* wt_ret_out = (bf16_t*)(ws + WS_WT_RET_OUT);
    float* ret_cos = (float*)(ws + WS_RET_COS); float* ret_sin = (float*)(ws + WS_RET_SIN); float* att_cos = (float*)(ws + WS_ATT_COS); float* att_sin = (float*)(ws + WS_ATT_SIN);
    float* lse = (float*)(ws + WS_LSE); bf16_t* hbuf = (bf16_t*)(ws + WS_H); bf16_t* proj = (bf16_t*)(ws + WS_PROJ);
    bf16_t* pool_diff = (bf16_t*)(ws + WS_PROJ + 256 * MiB); bf16_t* ret_out = (bf16_t*)(ws + WS_PROJ + 512 * MiB);

    unsigned* bar_ctr = (unsigned*)(ws + WS_END); unsigned bar_n = 0;
    grid.sync();
    int tid0 = threadIdx.x; asm volatile("" : "+v"(tid0));
    transpose_batch(tid0, lds, p.pool_w_in + 2048, wt_pool_in + (size_t)2048 * 1024, 1024, 2048, 2, 4096, (size_t)1024 * 4096, (size_t)4096 * 1024);
    convert_rows(tid0, p.pool_w_in, pool_diff, 1024, 2048, 4096); convert_rows(tid0, p.pool_w_in + (size_t)1024 * 4096, pool_diff + (size_t)1024 * 2048, 1024, 2048, 4096);
    transpose_batch(tid0, lds, p.pool_w_group, wt_pool_g, 512, 512, 8);
    transpose_batch(tid0, lds, p.pool_w_out, wt_pool_out, 2048, 1024, 2);
    bar_n += gridDim.x; grid_barrier(bar_ctr, bar_n);
    for (int l = 0; l < 2; ++l) { pg8::EpiStore E; E.O = wt_pool_in + (size_t)l * 4096 * 1024; E.ldc = 1024;
        run_gemm(tid0, lds, wt_pool_g + (size_t)l * 2048 * 512, 512, pool_diff + (size_t)l * 1024 * 2048, 2048, 2048, 1024, 512, 0, E, 2); }
    transpose_batch(tid0, lds, p.att_w_in, wt_att_in, 1024, 10240, 1);
    transpose_batch(tid0, lds, p.att_w_out, wt_att_out, 1024, 1024, 1);
    transpose_batch(tid0, lds, p.ret_w_in, wt_ret_in, 1024, 8192, 1);
    transpose_batch(tid0, lds, p.ret_w_out, wt_ret_out, 2048, 1024, 1);
    rope_tables(tid0, ret_cos, ret_sin, att_cos, att_sin);
    rmsnorm_phase(tid0, p.x, p.pool_norm, hbuf);
    bar_n += gridDim.x; grid_barrier(bar_ctr, bar_n);

    for (int ph = 0; ph < PH_N; ++ph) {
        int tid = threadIdx.x; asm volatile("" : "+v"(tid));
        const int code = PH_TAB[ph], lh = code >> 3, sub = code & 7, layer = lh >> 1, half = lh & 1;
        const int kind = layer % 3, idx = layer / 3;
        const size_t xo = (size_t)half * MH * DM;
        if (sub == 0) {
            int lo = layer; asm volatile("" : "+s"(lo));
            const float* xsrc = (lo == 0 ? p.x : p.out) + xo;
            rmsnorm_phase(tid, xsrc, kind == 0 ? p.pool_norm + idx * 1024 : (kind == 1 ? p.att_norm : p.ret_norm), hbuf);
        } else if (sub == 4) {
            const bf16_t* A = kind == 0 ? pool_diff : proj; const int lda = kind == 0 ? 2048 : (kind == 1 ? 10240 : 8192), K = kind == 1 ? 1024 : 2048;
            const bf16_t* Bt = kind == 0 ? wt_pool_out + (size_t)idx * 1024 * 2048 : (kind == 1 ? wt_att_out : wt_ret_out);
            int lo = layer; asm volatile("" : "+s"(lo));
            const float* xsrc = (lo == 0 ? p.x : p.out) + xo; float* xdst = p.out + xo;
            pg8::EpiResid E; E.base = xsrc; E.out = xdst; run_gemm(tid, lds, A, lda, Bt, K, MH, 1024, K, 0, E);
            if (lh + 1 < 8) { int l2 = (lh + 1) >> 1; const int h2 = (lh + 1) & 1, k2 = l2 % 3, i2 = l2 / 3; asm volatile("" : "+s"(l2));
                const float* xs2 = (l2 == 0 ? p.x : p.out) + (size_t)h2 * MH * DM;
                rmsnorm_phase(tid, xs2, k2 == 0 ? p.pool_norm + i2 * 1024 : (k2 == 1 ? p.att_norm : p.ret_norm), hbuf); }
        } else if (sub == 1) {
            if (kind == 2) { pg8::EpiRet E; E.O = proj; E.cosT = ret_cos; E.sinT = ret_sin; run_gemm(tid, lds, hbuf, 1024, wt_ret_in, 1024, MH, 8192, 1024, 0, E); }
            else { const int N = kind == 0 ? 4096 : 10240; const bf16_t* Bt = kind == 0 ? wt_pool_in + (size_t)idx * 4096 * 1024 : wt_att_in;
                pg8::EpiStore E; E.O = proj; E.ldc = N; run_gemm(tid, lds, hbuf, 1024, Bt, 1024, MH, N, 1024, 0, E); }
        } else if (sub == 2) {
            if (kind == 0) pool_mix_phase(tid, proj, p.pool_scale + idx * 2048, pool_diff);
            else if (kind == 1) attn_phase(tid, lds, proj, lse, p.att_q_norm, p.att_k_norm, att_cos, att_sin);
            else ret_chain_phase(tid, lds, proj, ret_out, p.ret_decay);
        } else if (sub == 3) {
            if (kind == 0) { }
            else if (kind == 1) attn_combine_phase(tid, proj, lse);
            else ret_combine_phase(tid, proj, ret_out);
        }
        if (ph + 1 < PH_N) { bar_n += gridDim.x; grid_barrier(bar_ctr, bar_n); }
    }
}

extern "C" void kernel_launch(void* const* d_in, const int* in_sizes, int n_in, void* d_out, int out_size, void* d_ws, size_t ws_size, hipStream_t stream) {
    constexpr int LDS_BYTES = 135168;
    static int grid_blocks = 0;
    if (grid_blocks == 0) {
        if (n_in != 15 || ws_size < WS_END + 256) { fprintf(stderr, "kernel_launch: unexpected n_in %d / ws_size %zu (need %zu)\n", n_in, ws_size, (size_t)WS_END); grid_blocks = -1; return; }
        int dev = 0, cus = 0, per_cu = 0;
        hipGetDevice(&dev);
        hipDeviceGetAttribute(&cus, hipDeviceAttributeMultiprocessorCount, dev);
        if (hipFuncSetAttribute((const void*)mega_fwd, hipFuncAttributeMaxDynamicSharedMemorySize, LDS_BYTES) != hipSuccess) { fprintf(stderr, "kernel_launch: hipFuncSetAttribute failed\n"); }
        hipOccupancyMaxActiveBlocksPerMultiprocessor(&per_cu, (const void*)mega_fwd, 512, LDS_BYTES);
        (void)hipGetLastError();
        if (per_cu < 1) per_cu = 1;
        grid_blocks = cus;
    }
    if (grid_blocks < 0) return;
    (void)hipMemsetAsync((unsigned char*)d_ws + WS_END, 0, 256, stream);
    Params p{};
    p.x = (const float*)d_in[0]; p.pool_norm = (const float*)d_in[1]; p.pool_w_in = (const float*)d_in[2]; p.pool_w_group = (const float*)d_in[3];
    p.pool_scale = (const float*)d_in[4]; p.pool_w_out = (const float*)d_in[5]; p.att_norm = (const float*)d_in[6]; p.att_w_in = (const float*)d_in[7];
    p.att_q_norm = (const float*)d_in[8]; p.att_k_norm = (const float*)d_in[9]; p.att_w_out = (const float*)d_in[10]; p.ret_norm = (const float*)d_in[11];
    p.ret_w_in = (const float*)d_in[12]; p.ret_decay = (const float*)d_in[13]; p.ret_w_out = (const float*)d_in[14];
    p.out = (float*)d_out; p.ws = (unsigned char*)d_ws;
    void* args[] = {&p};
    hipError_t e = hipLaunchCooperativeKernel((const void*)mega_fwd, dim3(grid_blocks), dim3(512), args, LDS_BYTES, stream);
    if (e != hipSuccess) fprintf(stderr, "cooperative launch failed: %s (grid %d)\n", hipGetErrorString(e), grid_blocks);
}
```
